# Optimizing an MI355X kernel written in HIP

```python
import jax, jax.numpy as jnp
from jax import lax
import numpy as np

D_MODEL = 2048
BATCH = 2
SEQ = 16384
DEPTH = 1

HEAD_DIM = 64
A_Q_HEADS = (3 * D_MODEL) // (4 * HEAD_DIM)
A_KV_HEADS = A_Q_HEADS // 4
B_HEADS = D_MODEL // (4 * HEAD_DIM)
B_CONFIGS = ((128, 1), (512, 4), (2048, 16))
N_B_GROUPS = len(B_CONFIGS)
A_Q_W = A_Q_HEADS * HEAD_DIM
A_KV_W = A_KV_HEADS * HEAD_DIM
B_W = B_HEADS * HEAD_DIM
MIX_WIDTH = A_Q_W + B_W
IN_WIDTH = A_Q_W + 2 * A_KV_W + 3 * N_B_GROUPS * B_W
GRID_W = 64
ROPE_THETA = 10000.0
Q_BLOCK = 128
N_EXPERTS = 32
TOP_K = 4
D_FF = D_MODEL
SWIGLU_LIMIT = 7.0
SWIGLU_ALPHA = 1.702
MOE_BLOCK = 512
NORM_EPS = 1e-5
QK_EPS = 1e-6

kernel_name = "hymba_gqa_axial_dilated_alibi_moe_encoder"


def rms_norm(x, w, eps):
    xf = x.astype(jnp.float32)
    y = xf * lax.rsqrt(jnp.mean(xf * xf, axis=-1, keepdims=True) + eps)
    return (y * w.astype(jnp.float32)).astype(x.dtype)


def axial_rope_tables(seq_len):
    rows = seq_len // GRID_W
    r, c = jnp.meshgrid(jnp.arange(rows), jnp.arange(GRID_W), indexing="ij")
    axis_dim = HEAD_DIM // 2
    inv = ROPE_THETA ** (-jnp.arange(0, axis_dim, 2, dtype=jnp.float32) / axis_dim)
    ang_r = r.reshape(-1).astype(jnp.float32)[:, None] * inv[None, :]
    ang_c = c.reshape(-1).astype(jnp.float32)[:, None] * inv[None, :]
    ang = jnp.concatenate([ang_r, ang_c], axis=-1)
    return jnp.cos(ang), jnp.sin(ang)


def rotate(xp, cos, sin):
    x1, x2 = jnp.split(xp, 2, axis=-1)
    return jnp.concatenate([x1 * cos - x2 * sin, x2 * cos + x1 * sin], axis=-1)


def apply_axial_rope(x, cos, sin):
    quarter = HEAD_DIM // 4
    cr, cc = cos[:, None, :quarter], cos[:, None, quarter:]
    sr, sc = sin[:, None, :quarter], sin[:, None, quarter:]
    xf = x.astype(jnp.float32)
    half = HEAD_DIM // 2
    out = jnp.concatenate([rotate(xf[..., :half], cr, sr), rotate(xf[..., half:], cc, sc)], axis=-1)
    return out.astype(x.dtype)


def gqa_axial_attention(q, k, v, q_norm_w, k_norm_w):
    B, S = q.shape[0], q.shape[1]
    q = rms_norm(q, q_norm_w, QK_EPS)
    k = rms_norm(k, k_norm_w, QK_EPS)
    cos, sin = axial_rope_tables(S)
    q = apply_axial_rope(q, cos, sin)
    k = apply_axial_rope(k, cos, sin)
    G = A_Q_HEADS // A_KV_HEADS
    scale = HEAD_DIM ** -0.5
    n_blk = S // Q_BLOCK
    qb_all = jnp.moveaxis(q.reshape(B, n_blk, Q_BLOCK, A_KV_HEADS, G, HEAD_DIM), 1, 0)

    def block(qb):
        s = jnp.einsum("bqhgd,bkhd->bhgqk", qb, k, preferred_element_type=jnp.float32) * scale
        p = jax.nn.softmax(s, axis=-1)
        return jnp.einsum("bhgqk,bkhd->bqhgd", p.astype(v.dtype), v)

    o = lax.map(block, qb_all)
    return jnp.moveaxis(o, 0, 1).reshape(B, S, A_Q_HEADS * HEAD_DIM)


def dilated_window_attention(q, k, v, window, dilation, slopes):
    B, S, H, D = q.shape
    radius = window // (2 * dilation)
    offs = jnp.arange(-radius, radius + 1)
    alibi = -slopes[:, None] * (dilation * jnp.abs(offs)).astype(jnp.float32)[None, :]
    scale = D ** -0.5
    n_blk = S // Q_BLOCK
    qb_all = jnp.moveaxis(q.reshape(B, n_blk, Q_BLOCK, H, D), 1, 0)

    def block(args):
        i, qb = args
        pos = i * Q_BLOCK + jnp.arange(Q_BLOCK)
        idx = pos[:, None] + dilation * offs[None, :]
        valid = (idx >= 0) & (idx < S)
        idx = jnp.clip(idx, 0, S - 1)
        kg = jnp.take(k, idx, axis=1)
        vg = jnp.take(v, idx, axis=1)
        s = jnp.einsum("bqhd,bqkhd->bhqk", qb, kg, preferred_element_type=jnp.float32) * scale
        s = s + alibi[None, :, None, :]
        s = jnp.where(valid[None, None], s, -jnp.inf)
        lse = jax.nn.logsumexp(s, axis=-1)
        p = jnp.exp(s - lse[..., None])
        o = jnp.einsum("bhqk,bqkhd->bqhd", p.astype(v.dtype), vg)
        return o, lse

    o, lse = lax.map(block, (jnp.arange(n_blk), qb_all))
    o = jnp.moveaxis(o, 0, 1).reshape(B, S, H, D)
    lse = jnp.transpose(lse, (1, 0, 3, 2)).reshape(B, S, H)
    return o, lse


def alibi_slopes(n_heads):
    return 2.0 ** (-8.0 * (jnp.arange(n_heads, dtype=jnp.float32) + 1.0) / n_heads)


def moe_ffn(xn, w_router, b_router, w_gate_up, b_gate_up, w_down, b_down):
    N, D = xn.shape
    logits = jnp.einsum("nd,de->ne", xn, w_router, preferred_element_type=jnp.float32) + b_router.astype(jnp.float32)
    top_vals, top_idx = lax.top_k(logits, TOP_K)
    gates = jax.nn.softmax(top_vals, axis=-1)
    A = N * TOP_K
    flat_e = top_idx.reshape(-1)
    flat_tok = jnp.repeat(jnp.arange(N, dtype=jnp.int32), TOP_K)
    flat_g = gates.reshape(-1)
    order = jnp.argsort(flat_e)
    sorted_e = flat_e[order]
    counts = jnp.bincount(flat_e, length=N_EXPERTS)
    start = jnp.cumsum(counts) - counts
    rank = jnp.arange(A, dtype=jnp.int32) - start[sorted_e]
    padded = (counts + MOE_BLOCK - 1) // MOE_BLOCK * MOE_BLOCK
    pend = jnp.cumsum(padded)
    pstart = pend - padded
    dest = pstart[sorted_e] + rank
    n_blocks = -(-A // MOE_BLOCK) + N_EXPERTS
    cap = n_blocks * MOE_BLOCK
    tok_buf = jnp.full((cap,), N, jnp.int32).at[dest].set(flat_tok[order])
    gate_buf = jnp.zeros((cap,), jnp.float32).at[dest].set(flat_g[order])
    blk_e = jnp.minimum(jnp.searchsorted(pend, jnp.arange(n_blocks) * MOE_BLOCK, side="right"), N_EXPERTS - 1)
    x_pad = jnp.concatenate([xn, jnp.zeros((1, D), xn.dtype)], axis=0)

    def expert_block(args):
        e, toks, g = args
        xb = x_pad[toks]
        hgu = xb @ w_gate_up[e] + b_gate_up[e]
        gate, up = jnp.split(hgu, 2, axis=-1)
        gate = jnp.minimum(gate, SWIGLU_LIMIT)
        up = jnp.clip(up, -SWIGLU_LIMIT, SWIGLU_LIMIT)
        act = (up + 1.0) * gate * jax.nn.sigmoid(SWIGLU_ALPHA * gate)
        y = act @ w_down[e] + b_down[e]
        return y.astype(jnp.float32) * g[:, None]

    y = lax.map(expert_block, (blk_e, tok_buf.reshape(n_blocks, MOE_BLOCK), gate_buf.reshape(n_blocks, MOE_BLOCK)))
    out = jax.ops.segment_sum(y.reshape(cap, D), tok_buf, num_segments=N + 1)[:N]
    return out.astype(xn.dtype)


def setup_inputs(seed: int = 0) -> dict:
    key = jax.random.key(seed)
    ks = jax.random.split(key, 16)
    f32 = jnp.float32
    L, D, E, F = DEPTH, D_MODEL, N_EXPERTS, D_FF

    def nrm(k, shape, scale):
        return jax.random.normal(k, shape, f32) * scale

    return {
        "x": jax.random.normal(ks[0], (BATCH, SEQ, D), f32),
        "norm_mix_w": 1.0 + nrm(ks[1], (L, D), 0.02),
        "w_in": nrm(ks[2], (L, D, IN_WIDTH), D ** -0.5),
        "q_norm_w": 1.0 + nrm(ks[3], (L, HEAD_DIM), 0.02),
        "k_norm_w": 1.0 + nrm(ks[4], (L, HEAD_DIM), 0.02),
        "out_norm_w": 1.0 + nrm(ks[5], (L, MIX_WIDTH), 0.02),
        "w_out": nrm(ks[6], (L, MIX_WIDTH, D), MIX_WIDTH ** -0.5),
        "norm_moe_w": 1.0 + nrm(ks[7], (L, D), 0.02),
        "w_router": nrm(ks[8], (L, D, E), D ** -0.5),
        "b_router": nrm(ks[9], (L, E), 0.01),
        "w_gate_up": nrm(ks[10], (L, E, D, 2 * F), D ** -0.5),
        "b_gate_up": nrm(ks[11], (L, E, 2 * F), 0.02),
        "w_down": nrm(ks[12], (L, E, F, D), F ** -0.5),
        "b_down": nrm(ks[13], (L, E, D), 0.02),
        "final_norm_w": 1.0 + nrm(ks[14], (D,), 0.02),
    }


def reference(x, norm_mix_w, w_in, q_norm_w, k_norm_w, out_norm_w, w_out, norm_moe_w,
              w_router, b_router, w_gate_up, b_gate_up, w_down, b_down, final_norm_w):
    B, S, D = x.shape
    slopes = alibi_slopes(B_HEADS)
    for l in range(DEPTH):
        h = rms_norm(x, norm_mix_w[l], NORM_EPS)
        p = jnp.einsum("bsd,de->bse", h, w_in[l])
        qa = p[..., :A_Q_W].reshape(B, S, A_Q_HEADS, HEAD_DIM)
        ka = p[..., A_Q_W:A_Q_W + A_KV_W].reshape(B, S, A_KV_HEADS, HEAD_DIM)
        va = p[..., A_Q_W + A_KV_W:A_Q_W + 2 * A_KV_W].reshape(B, S, A_KV_HEADS, HEAD_DIM)
        o_a = gqa_axial_attention(qa, ka, va, q_norm_w[l], k_norm_w[l])

        base = A_Q_W + 2 * A_KV_W
        outs, lses = [], []
        for g, (window, dilation) in enumerate(B_CONFIGS):
            off = base + g * 3 * B_W
            qb = p[..., off:off + B_W].reshape(B, S, B_HEADS, HEAD_DIM)
            kb = p[..., off + B_W:off + 2 * B_W].reshape(B, S, B_HEADS, HEAD_DIM)
            vb = p[..., off + 2 * B_W:off + 3 * B_W].reshape(B, S, B_HEADS, HEAD_DIM)
            o_g, lse_g = dilated_window_attention(qb, kb, vb, window, dilation, slopes)
            outs.append(o_g)
            lses.append(lse_g)
        wts = jax.nn.softmax(jnp.stack(lses, axis=0), axis=0)
        o_b = jnp.sum(wts[..., None] * jnp.stack(outs, axis=0).astype(jnp.float32), axis=0)
        o_b = o_b.astype(x.dtype).reshape(B, S, B_W)

        merged = jnp.concatenate([
            rms_norm(o_a, out_norm_w[l, :A_Q_W], NORM_EPS),
            rms_norm(o_b, out_norm_w[l, A_Q_W:], NORM_EPS),
        ], axis=-1)
        x = x + jnp.einsum("bse,ed->bsd", merged, w_out[l])

        hm = rms_norm(x, norm_moe_w[l], NORM_EPS).reshape(B * S, D)
        y = moe_ffn(hm, w_router[l], b_router[l], w_gate_up[l], b_gate_up[l], w_down[l], b_down[l])
        x = x + y.reshape(B, S, D)
    return rms_norm(x, final_norm_w, NORM_EPS)
```

```cpp
#include <hip/hip_runtime.h>
#include <hip/hip_bf16.h>
#include <cstdio>
#include <cstdint>
#include <cmath>

#ifndef MK_SPLIT
#define MK_SPLIT 0
#endif

namespace pg8 {
#define PG8_LAS __attribute__((address_space(3)))
typedef unsigned short bf16_t;
typedef short bf16x8 __attribute__((ext_vector_type(8)));
typedef float f32x4 __attribute__((ext_vector_type(4)));
typedef unsigned u32x4 __attribute__((ext_vector_type(4)));
typedef unsigned u32x2 __attribute__((ext_vector_type(2)));
constexpr int BM = 256, BK = 64, HALF = 128, HTB = HALF * BK * 2  , STAGE_BYTES = 8 * HTB, NXCD = 8, WGM = 8;

__host__ __device__ __forceinline__ int lds_byte(int r, int c) { const int st = (r >> 4) * 2 + (c >> 5), rr = r & 15, cc = c & 31, ob = rr * 64 + cc * 2; return st * 1024 + (ob ^ (((ob >> 9) & 1) << 5)); }
__host__ __device__ __forceinline__ void stage_rc(int b, int& R, int& C) { const int st = b / 1024, sb = b % 1024, swz = sb ^ (((sb >> 9) & 1) << 5); R = (st >> 1) * 16 + swz / 64; C = (st & 1) * 32 + (swz % 64) / 2; }
__host__ __device__ __forceinline__ int perm32(int rho) { const int n = rho >> 4, i = rho & 15; return 8 * (i >> 2) + 4 * n + (i & 3); }

struct Unit { int pm, pn, e, r0, cnt; };

struct StaticOrder {
    int nM, nN, nwg, G, c;
    __device__ __forceinline__ void init(int nM_, int nN_, int G_, int c_) { nM = nM_; nN = nN_; nwg = nM * nN; G = G_; c = c_; }
    __device__ __forceinline__ bool next(int i, Unit& u) const { return at((long)i * G + c, u); }
    __device__ __forceinline__ bool at(const long L, Unit& u) const {
        if (L >= nwg) return false;
        int wgid = (int)L; { const int q = nwg / NXCD, r = nwg % NXCD, xcd = wgid % NXCD, off = wgid / NXCD; wgid = (xcd < r ? xcd * (q + 1) : r * (q + 1) + (xcd - r) * q) + off; }
        const int nig = WGM * nN, gid = wgid / nig, fm = gid * WGM, gsz = (nM - fm) < WGM ? (nM - fm) : WGM;
        u.pm = fm + ((wgid % nig) % gsz); u.pn = (wgid % nig) / gsz; u.e = 0; u.r0 = 0; u.cnt = 0; return true;
    }
    __device__ __forceinline__ int apos(const Unit& u) const { return u.pm; }
    __device__ __forceinline__ int bpos(const Unit& u) const { return u.pn; }
    __device__ __forceinline__ void a_ready(const Unit&) const {}
    __device__ __forceinline__ void done(const Unit&) const {}
};
struct BalancedOrder {
    StaticOrder so; int n_long, r_all, r_extra;
    __device__ __forceinline__ void init(int nM_, int nN_, int G_, int c_, int n_long_, int long_cost, int unit_cost) {
        so.init(nM_, nN_, G_, c_); n_long = n_long_;
        int k = (n_long > 0 && n_long < G_) ? long_cost / unit_cost : 0; int ra = (so.nwg - (G_ - n_long) * k) / G_;
        if (k > 0 && ra >= 0 && ra * G_ + (G_ - n_long) * k == so.nwg) { r_all = ra; r_extra = k; } else { r_all = (so.nwg + G_ - 1) / G_; r_extra = 0; n_long = 0; }
    }
    __device__ __forceinline__ bool next(int i, Unit& u) const {
        if (r_extra == 0) return so.next(i, u);
        long L;
        if (i < r_all) L = (long)i * so.G + so.c; else if (so.c >= n_long && i < r_all + r_extra) L = (long)r_all * so.G + (long)(i - r_all) * (so.G - n_long) + (so.c - n_long); else return false;
        if (L >= so.nwg) return false;
        StaticOrder t = so; t.c = 0; t.G = 1; return t.next((int)L, u);
    }
    __device__ __forceinline__ int apos(const Unit& u) const { return u.pm; }
    __device__ __forceinline__ int bpos(const Unit& u) const { return u.pn; }
    __device__ __forceinline__ void a_ready(const Unit&) const {}
    __device__ __forceinline__ void done(const Unit&) const {}
};
struct DynTail {
    unsigned* qh; PG8_LAS int* qw; int r_s; mutable unsigned pend; mutable int last_i;
    __device__ __forceinline__ void init(unsigned* qh_, PG8_LAS int* qw_, int nwg, int G, int tail = 2) { qh = qh_; qw = qw_; const int ra = nwg / G; r_s = ra >= 2 ? (ra - tail > 2 ? ra - tail : 2) : 0x3fffffff; pend = 0u; last_i = 0; }
    __device__ __forceinline__ long pos(int i, int G, int c) const {
        long L = (long)i * G + c;
        if (i >= r_s) L = (long)r_s * G + __builtin_amdgcn_readfirstlane(*qw);
        last_i = i;
        if (i >= r_s - 1 && threadIdx.x == 0) pend = __hip_atomic_fetch_add(qh, 1u, __ATOMIC_RELAXED, __HIP_MEMORY_SCOPE_AGENT);
        return L;
    }
    __device__ __forceinline__ void publish() const { if (last_i >= r_s - 1 && threadIdx.x == 0) *qw = (int)pend; }
};
struct DynOrder {
    StaticOrder so; DynTail dt;
    __device__ __forceinline__ void init(int nM_, int nN_, int G_, int c_, unsigned* qh, PG8_LAS int* qw, int tail) { so.init(nM_, nN_, G_, c_); dt.init(qh, qw, so.nwg, G_, tail); }
    __device__ __forceinline__ bool next(int i, Unit& u) const { return so.at(dt.pos(i, so.G, so.c), u); }
    __device__ __forceinline__ int apos(const Unit& u) const { return u.pm; }
    __device__ __forceinline__ int bpos(const Unit& u) const { return u.pn; }
    __device__ __forceinline__ void a_ready(const Unit&) const { dt.publish(); }
    __device__ __forceinline__ void done(const Unit&) const {}
};
struct MoeOrder {
    StaticOrder so; const PG8_LAS int* tile_e; DynTail dt;
    __device__ __forceinline__ bool next(int i, Unit& u) const { if (!so.at(dt.pos(i, so.G, so.c), u)) return false; u.e = __builtin_amdgcn_readfirstlane(tile_e[u.pm]); return true; }
    __device__ __forceinline__ int apos(const Unit& u) const { return u.pm; }
    __device__ __forceinline__ int bpos(const Unit& u) const { return u.e * so.nN + u.pn; }
    __device__ __forceinline__ void a_ready(const Unit&) const { dt.publish(); }
    __device__ __forceinline__ void done(const Unit&) const {}
};

struct MoeGatherOrder {
    StaticOrder so; const PG8_LAS int* tile_e; const PG8_LAS int* ppad; const PG8_LAS int* ecnt; const int* tokof; PG8_LAS int* tokbuf; DynTail dt;
    __device__ __forceinline__ bool next(int i, Unit& u) const { if (!so.at(dt.pos(i, so.G, so.c), u)) return false; u.e = __builtin_amdgcn_readfirstlane(tile_e[u.pm]);
        u.r0 = 256 * (u.pm - (__builtin_amdgcn_readfirstlane(ppad[u.e]) >> 8)); u.cnt = __builtin_amdgcn_readfirstlane(ecnt[u.e]); return true; }
    __device__ __forceinline__ int apos(const Unit&) const { return 0; }
    __device__ __forceinline__ int bpos(const Unit& u) const { return u.e * so.nN + u.pn; }
    __device__ __forceinline__ void a_ready(const Unit&) const { dt.publish(); }
    __device__ __forceinline__ void done(const Unit&) const {}
};

__device__ __forceinline__ unsigned cvt_pk_bf16(float lo, float hi) { unsigned r; asm volatile("v_cvt_pk_bf16_f32 %0, %1, %2" : "=v"(r) : "v"(lo), "v"(hi)); return r; }

typedef int v8i_t __attribute__((ext_vector_type(8)));
typedef int v4i_t __attribute__((ext_vector_type(4)));
__device__ __forceinline__ f32x4 mfma_f8(bf16x8 b0, bf16x8 b1, bf16x8 a0, bf16x8 a1, f32x4 c) {
    const v4i_t x0 = __builtin_bit_cast(v4i_t, b0), x1 = __builtin_bit_cast(v4i_t, b1), y0 = __builtin_bit_cast(v4i_t, a0), y1 = __builtin_bit_cast(v4i_t, a1);
    const v8i_t X = {x0.x, x0.y, x0.z, x0.w, x1.x, x1.y, x1.z, x1.w}, Y = {y0.x, y0.y, y0.z, y0.w, y1.x, y1.y, y1.z, y1.w};
    return __builtin_amdgcn_mfma_scale_f32_16x16x128_f8f6f4(X, Y, c, 0, 0, 0, 0x7F7F7F7F, 0, 0x7F7F7F7F);
}
__device__ __forceinline__ unsigned pk4_fp8(float a, float b, float c, float d) { int p = __builtin_amdgcn_cvt_pk_fp8_f32(a, b, 0, false); p = __builtin_amdgcn_cvt_pk_fp8_f32(c, d, p, true); return (unsigned)p; }

struct EpiBf16 {
    static constexpr bool PERM = true, AFTER_DRAIN = false, BIAS_DMA = false;
    bf16_t* O; int ldc; const float* bias; int bias_estride; float scale;
    __device__ __forceinline__ void operator()(const f32x4 (&acc)[2][2][4][2], const Unit& u, int wr, int wc, int fr, int fq) const {
        const int row0 = u.pm * BM + wr * 64 + fr; const int col0 = u.pn * BM + wc * 32 + 8 * fq;
        f32x4 bv[2][2];
#pragma unroll
        for (int bj = 0; bj < 2; ++bj)
#pragma unroll
            for (int n = 0; n < 2; ++n) bv[bj][n] = bias ? *(const f32x4*)(bias + (size_t)u.e * bias_estride + col0 + bj * HALF + 4 * n) : (f32x4){0.f, 0.f, 0.f, 0.f};
#pragma unroll
        for (int ai = 0; ai < 2; ++ai)
#pragma unroll
            for (int m = 0; m < 4; ++m) { bf16_t* rowp = O + (size_t)(row0 + ai * HALF + m * 16) * ldc + col0;
#pragma unroll
                for (int bj = 0; bj < 2; ++bj) { const f32x4 v0 = acc[ai][bj][m][0] * scale + bv[bj][0], v1 = acc[ai][bj][m][1] * scale + bv[bj][1];
                    u32x4 w; w.x = cvt_pk_bf16(v0[0], v0[1]); w.y = cvt_pk_bf16(v0[2], v0[3]); w.z = cvt_pk_bf16(v1[0], v1[1]); w.w = cvt_pk_bf16(v1[2], v1[3]);
                    *(u32x4*)(rowp + bj * HALF) = w; } }
    }
};
struct EpiInProj {
    static constexpr bool PERM = true, AFTER_DRAIN = false, BIAS_DMA = false;
    bf16_t* P; bf16_t* PB; int pn_off; float scale;
    __device__ __forceinline__ void operator()(const f32x4 (&acc)[2][2][4][2], const Unit& u, int wr, int wc, int fr, int fq) const {
        const int row0 = u.pm * BM + wr * 64 + fr; const int upn = u.pn + pn_off;
        if (upn < 9) {
            const int col0 = upn * BM + wc * 32 + 8 * fq;
#pragma unroll
            for (int ai = 0; ai < 2; ++ai)
#pragma unroll
                for (int m = 0; m < 4; ++m) { bf16_t* rowp = P + (size_t)(row0 + ai * HALF + m * 16) * 2304 + col0;
#pragma unroll
                    for (int bj = 0; bj < 2; ++bj) { const f32x4 v0 = acc[ai][bj][m][0], v1 = acc[ai][bj][m][1];
                        u32x4 w; w.x = cvt_pk_bf16(v0[0], v0[1]); w.y = cvt_pk_bf16(v0[2], v0[3]); w.z = cvt_pk_bf16(v1[0], v1[1]); w.w = cvt_pk_bf16(v1[2], v1[3]);
                        *(u32x4*)(rowp + bj * HALF) = w; } }
        } else {
            const int cb0 = (upn - 9) * BM, g = cb0 / 1536, rem0 = cb0 % 1536, kind = rem0 / 512, dsh = 2 * g, b = (u.pm * BM) >> 14;
            const int d0 = (32 * wc + 8 * fq) & 63;
#pragma unroll
            for (int bj = 0; bj < 2; ++bj) { const int hh = ((rem0 & 511) + 128 * bj + 32 * wc) >> 6;
                bf16_t* base = PB + ((size_t)((((g * 3 + kind) * 2 + b) * 8 + hh)) << 20) + d0;
#pragma unroll
                for (int ai = 0; ai < 2; ++ai)
#pragma unroll
                    for (int m = 0; m < 4; ++m) { const int s = (row0 + ai * HALF + m * 16) & 16383; const int rr = ((s & ((1 << dsh) - 1)) << (14 - dsh)) + (s >> dsh);
                        const f32x4 v0 = acc[ai][bj][m][0] * scale, v1 = acc[ai][bj][m][1] * scale;
                        u32x4 w; w.x = cvt_pk_bf16(v0[0], v0[1]); w.y = cvt_pk_bf16(v0[2], v0[3]); w.z = cvt_pk_bf16(v1[0], v1[1]); w.w = cvt_pk_bf16(v1[2], v1[3]);
                        *(u32x4*)(base + (size_t)rr * 64) = w; } }
        }
    }
};
struct EpiResidBf16 {
    static constexpr bool PERM = true, AFTER_DRAIN = false, BIAS_DMA = false;
    const float* X; bf16_t* O; int ldc;
    __device__ __forceinline__ void operator()(const f32x4 (&acc)[2][2][4][2], const Unit& u, int wr, int wc, int fr, int fq) const {
        const int row0 = u.pm * BM + wr * 64 + fr; const int col0 = u.pn * BM + wc * 32 + 8 * fq;
#pragma unroll
        for (int ai = 0; ai < 2; ++ai)
#pragma unroll
            for (int m = 0; m < 4; ++m) { const size_t off = (size_t)(row0 + ai * HALF + m * 16) * ldc + col0;
#pragma unroll
                for (int bj = 0; bj < 2; ++bj) { const f32x4 x0 = *(const f32x4*)(X + off + bj * HALF), x1 = *(const f32x4*)(X + off + bj * HALF + 4);
                    const f32x4 v0 = x0 + acc[ai][bj][m][0], v1 = x1 + acc[ai][bj][m][1];
                    u32x4 w; w.x = cvt_pk_bf16(v0[0], v0[1]); w.y = cvt_pk_bf16(v0[2], v0[3]); w.z = cvt_pk_bf16(v1[0], v1[1]); w.w = cvt_pk_bf16(v1[2], v1[3]);
                    *(u32x4*)(O + off + bj * HALF) = w; } }
    }
};
struct EpiFp8 {
    static constexpr bool PERM = true, AFTER_DRAIN = false, BIAS_DMA = true;
    unsigned char* O; int ldc; const float* bias; int bias_estride; float scale; PG8_LAS float* bbuf;
    __device__ __forceinline__ void bias_dma(const Unit& u, int ui, int lane) const {
        __builtin_amdgcn_global_load_lds((const unsigned*)(bias + (size_t)u.e * bias_estride + u.pn * BM + 4 * lane), (PG8_LAS unsigned*)(bbuf + (ui & 1) * 256), 16, 0, 0); }
    __device__ __forceinline__ void operator()(const f32x4 (&acc)[2][2][4][2], const Unit& u, int wr, int wc, int fr, int fq, int ui) const {
        const int row0 = u.pm * BM + wr * 64 + fr; const int col0 = u.pn * BM + wc * 32 + 8 * fq;
        const PG8_LAS float* bb = bbuf + (ui & 1) * 256 + wc * 32 + 8 * fq;
        f32x4 bv[2][2];
#pragma unroll
        for (int bj = 0; bj < 2; ++bj)
#pragma unroll
            for (int n = 0; n < 2; ++n) bv[bj][n] = *(const PG8_LAS f32x4*)(bb + bj * HALF + 4 * n);
#pragma unroll
        for (int ai = 0; ai < 2; ++ai)
#pragma unroll
            for (int m = 0; m < 4; ++m) { unsigned char* rowp = O + (size_t)(row0 + ai * HALF + m * 16) * ldc + col0;
#pragma unroll
                for (int bj = 0; bj < 2; ++bj) { const f32x4 v0 = acc[ai][bj][m][0] * scale + bv[bj][0], v1 = acc[ai][bj][m][1] * scale + bv[bj][1];
                    u32x2 w; w.x = pk4_fp8(v0[0], v0[1], v0[2], v0[3]); w.y = pk4_fp8(v1[0], v1[1], v1[2], v1[3]);
                    *(u32x2*)(rowp + bj * HALF) = w; } }
    }
};
struct EpiSwiglu {
    static constexpr bool PERM = true, AFTER_DRAIN = false, BIAS_DMA = true;
    unsigned char* H; const float* bgu; float scale; PG8_LAS float* bbuf;
    __device__ __forceinline__ void bias_dma(const Unit& u, int ui, int lane) const {
        __builtin_amdgcn_global_load_lds((const unsigned*)(bgu + (size_t)u.e * 4096 + u.pn * HALF + (lane >> 5) * 2048 + 4 * (lane & 31)), (PG8_LAS unsigned*)(bbuf + (ui & 1) * 256), 16, 0, 0); }
    __device__ __forceinline__ float act(float g, float up) const {
        g = fminf(g, 7.0f); up = fminf(fmaxf(up, -7.0f), 7.0f);
        const float sg = __builtin_amdgcn_rcpf(1.0f + __builtin_amdgcn_exp2f(-1.702f * 1.4426950408889634f * g));
        return (up + 1.0f) * g * sg;
    }
    __device__ __forceinline__ void operator()(const f32x4 (&acc)[2][2][4][2], const Unit& u, int wr, int wc, int fr, int fq, int ui) const {
        const int row0 = u.pm * BM + wr * 64 + fr; const int colh = u.pn * HALF + wc * 32 + 8 * fq;
        const PG8_LAS float* bg = bbuf + (ui & 1) * 256 + wc * 32 + 8 * fq;
        const f32x4 bg0 = *(const PG8_LAS f32x4*)(bg), bg1 = *(const PG8_LAS f32x4*)(bg + 4), bu0 = *(const PG8_LAS f32x4*)(bg + 128), bu1 = *(const PG8_LAS f32x4*)(bg + 132);
#pragma unroll
        for (int ai = 0; ai < 2; ++ai)
#pragma unroll
            for (int m = 0; m < 4; ++m) { unsigned char* rowp = H + (size_t)(row0 + ai * HALF + m * 16) * 2048 + colh;
                const f32x4 g0 = acc[ai][0][m][0] * scale + bg0, g1 = acc[ai][0][m][1] * scale + bg1, u0 = acc[ai][1][m][0] * scale + bu0, u1 = acc[ai][1][m][1] * scale + bu1;
                u32x2 w; w.x = pk4_fp8(act(g0[0], u0[0]), act(g0[1], u0[1]), act(g0[2], u0[2]), act(g0[3], u0[3]));
                w.y = pk4_fp8(act(g1[0], u1[0]), act(g1[1], u1[1]), act(g1[2], u1[2]), act(g1[3], u1[3]));
                *(u32x2*)rowp = w; }
    }
};

template <class Epi, class Sched, bool ALIGN_EPI = false, bool SP2 = false, bool F8 = false, bool GATHER = false>
__device__ __forceinline__ void gemm_phase(PG8_LAS unsigned char* lds, const int K, const char* Abase, const char* Bbase, const Sched& S, const Epi& E) {
    const int tid = threadIdx.x, wid = __builtin_amdgcn_readfirstlane(tid >> 6), lane = tid & 63, wr = wid >> 2, wc = wid & 3, fr = lane & 15, fq = lane >> 4;
    const int nt = K / BK;
    static_assert(SP2, "only the two-super-phase loop is kept");
    unsigned voffB[2], vAc[2][2], vAn[2][2]; int RA[2]; unsigned CA2[2];
#pragma unroll
    for (int i = 0; i < 2; ++i) { int R, C; stage_rc(tid * 16 + i * 8192, R, C); const int Rb = Epi::PERM ? ((R & ~31) + perm32(R & 31)) : R;
        RA[i] = R; CA2[i] = (unsigned)C * 2u; voffB[i] = (unsigned)(Rb * K + C) * 2u; }
    const size_t kstep = (size_t)(BK * 2);
    const size_t hstep = (size_t)HALF * K * 2;
    const size_t tstep = 2 * hstep;
#pragma unroll
    for (int h = 0; h < 2; ++h)
#pragma unroll
        for (int i = 0; i < 2; ++i) vAc[h][i] = vAn[h][i] = (unsigned)(RA[i] * K) * 2u + CA2[i] + (unsigned)(h * hstep);
#define PG8_TOKDMA(slot, U) do { if (wid == 0) __builtin_amdgcn_global_load_lds((const unsigned*)(S.tokof + (size_t)(U).e * 32768 + (U).r0 + 4 * lane), (PG8_LAS unsigned*)(S.tokbuf + (slot) * 256), 16, 0, 0); } while (0)
#define PG8_TOKOFF(dst, slot, U) do { const PG8_LAS int* tb_ = S.tokbuf + (slot) * 256; _Pragma("unroll") for (int h_ = 0; h_ < 2; ++h_) _Pragma("unroll") for (int i_ = 0; i_ < 2; ++i_) { \
        const int rk_ = 128 * h_ + RA[i_]; int tk_ = tb_[rk_]; tk_ = ((U).r0 + rk_ < (U).cnt) ? tk_ : 0; dst[h_][i_] = (unsigned)tk_ * (unsigned)(2 * K) + CA2[i_]; } } while (0)
    const unsigned ldsw = (unsigned)wid * 1024u;
    const int aoff = lds_byte(wr * 64 + fr, fq * 8), boff = lds_byte(wc * 32 + fr, fq * 8);
#define PG8_SA(b, h) (((b) * 2 + (h)) * HTB)
#define PG8_SB(b, h) ((4 + (b) * 2 + (h)) * HTB)
#define PG8_STAGE(bufoff, RS, goff, voff) do { _Pragma("unroll") for (int _i = 0; _i < 2; ++_i) \
        __builtin_amdgcn_raw_ptr_buffer_load_lds(RS, (PG8_LAS void*)(lds + (bufoff) + ldsw + _i * 8192), 16, (voff)[_i], (goff), 0, 0); } while (0)
#define PG8_LDA(dst, b, h) do { if constexpr (F8) { _Pragma("unroll") for (int m = 0; m < 4; ++m) { dst##8[m].lo = *(const PG8_LAS v4i_t*)(lds + PG8_SA(b, h) + aoff + m * 2048); dst##8[m].hi = *(const PG8_LAS v4i_t*)(lds + PG8_SA(b, h) + aoff + m * 2048 + 1024); } } \
    else { _Pragma("unroll") for (int m = 0; m < 4; ++m) _Pragma("unroll") for (int k = 0; k < 2; ++k) dst[m][k] = *(const PG8_LAS bf16x8*)(lds + PG8_SA(b, h) + aoff + m * 2048 + k * 1024); } } while (0)
#define PG8_LDB(dst, b, h) do { if constexpr (F8) { _Pragma("unroll") for (int n = 0; n < 2; ++n) { dst##8[n].lo = *(const PG8_LAS v4i_t*)(lds + PG8_SB(b, h) + boff + n * 2048); dst##8[n].hi = *(const PG8_LAS v4i_t*)(lds + PG8_SB(b, h) + boff + n * 2048 + 1024); } } \
    else { _Pragma("unroll") for (int n = 0; n < 2; ++n) _Pragma("unroll") for (int k = 0; k < 2; ++k) dst[n][k] = *(const PG8_LAS bf16x8*)(lds + PG8_SB(b, h) + boff + n * 2048 + k * 1024); } } while (0)
#define PG8_MMA(ai, bj, At, Bt) do { __builtin_amdgcn_s_setprio(1); if constexpr (F8) { _Pragma("unroll") for (int m = 0; m < 4; ++m) _Pragma("unroll") for (int n = 0; n < 2; ++n) \
        asm volatile("v_mfma_f32_16x16x128_f8f6f4 %0, %1, %2, %0" : "+v"(acc[ai][bj][m][n]) : "v"(Bt##8[n]), "v"(At##8[m])); } else { _Pragma("unroll") for (int m = 0; m < 4; ++m) _Pragma("unroll") for (int n = 0; n < 2; ++n) _Pragma("unroll") for (int k = 0; k < 2; ++k) \
        acc[ai][bj][m][n] = __builtin_amdgcn_mfma_f32_16x16x32_bf16(Bt[n][k], At[m][k], acc[ai][bj][m][n], 0, 0, 0); } __builtin_amdgcn_s_setprio(0); } while (0)
#define PG8_WAIT_V(n) asm volatile("s_waitcnt vmcnt(" #n ")" ::: "memory")
#define PG8_WAIT_L(n) asm volatile("s_waitcnt lgkmcnt(" #n ")" ::: "memory")
#define PG8_BAR __builtin_amdgcn_s_barrier()
#define PG8_SCHED __builtin_amdgcn_sched_barrier(0)
    Unit cur, nxt; int ui = 0;
    if (!S.next(0, cur)) return;
    f32x4 acc[2][2][4][2];
#pragma unroll
    for (int a = 0; a < 2; ++a)
#pragma unroll
        for (int b = 0; b < 2; ++b)
#pragma unroll
            for (int m = 0; m < 4; ++m)
#pragma unroll
                for (int n = 0; n < 2; ++n) acc[a][b][m][n] = (f32x4){0.f, 0.f, 0.f, 0.f};
    bf16x8 At[4][2], B0[2][2], B1[2][2]; v8i_t At8[4], B08[2], B18[2];
    const __amdgpu_buffer_rsrc_t rsA = __builtin_amdgcn_make_buffer_rsrc((void*)Abase, 0, 0x7fffffff, 0x00020000), rsB = __builtin_amdgcn_make_buffer_rsrc((void*)Bbase, 0, 0x7fffffff, 0x00020000);
    unsigned cA = (unsigned)((size_t)S.apos(cur) * tstep), cB = (unsigned)((size_t)S.bpos(cur) * tstep);
    S.a_ready(cur);
    if constexpr (GATHER) { PG8_TOKDMA(0, cur); PG8_WAIT_V(0); PG8_BAR; PG8_TOKOFF(vAc, 0, cur); PG8_WAIT_L(0); }
    {
        PG8_STAGE(PG8_SB(0, 0), rsB, cB, voffB); PG8_STAGE(PG8_SB(0, 1), rsB, cB + (unsigned)hstep, voffB); PG8_STAGE(PG8_SA(0, 0), rsA, cA, vAc[0]); PG8_STAGE(PG8_SA(0, 1), rsA, cA, vAc[1]);
        if (wr == 1) PG8_BAR;
        PG8_WAIT_V(2); PG8_BAR;
        PG8_STAGE(PG8_SB(1, 0), rsB, cB + (unsigned)kstep, voffB); PG8_STAGE(PG8_SA(1, 0), rsA, cA + (unsigned)kstep, vAc[0]); PG8_STAGE(PG8_SB(1, 1), rsB, cB + (unsigned)(hstep + kstep), voffB);
        PG8_WAIT_V(6); PG8_BAR;
    }
    for (;;) {
        const bool has_next = S.next(ui + 1, nxt);
        const unsigned nA = has_next ? (unsigned)((size_t)S.apos(nxt) * tstep) : cA; const unsigned nB = has_next ? (unsigned)((size_t)S.bpos(nxt) * tstep) : cB;
        if constexpr (Epi::BIAS_DMA) { if (wid == 1) E.bias_dma(cur, ui, lane); }
        if constexpr (GATHER) { if (has_next) PG8_TOKDMA((ui + 1) & 1, nxt); }
        for (int t = 0; t < nt; t += 2) {
            const bool last = (t == nt - 2);
            const unsigned a1 = cA + (unsigned)((t + 1) * kstep);
            const unsigned a2 = last ? nA : cA + (unsigned)((t + 2) * kstep); const unsigned b2 = last ? nB : cB + (unsigned)((t + 2) * kstep);
            const unsigned a3 = a2 + (unsigned)kstep; const unsigned b3 = b2 + (unsigned)kstep;
            if (last && has_next) S.a_ready(nxt);
            if constexpr (GATHER) { if (last && has_next) { PG8_TOKOFF(vAn, (ui + 1) & 1, nxt); } }
            const unsigned v20 = last ? vAn[0][0] : vAc[0][0], v21 = last ? vAn[0][1] : vAc[0][1], v30 = last ? vAn[1][0] : vAc[1][0], v31 = last ? vAn[1][1] : vAc[1][1];
            const unsigned vx0[2] = {v20, v21}, vx1[2] = {v30, v31};
            PG8_LDB(B0, 0, 0); PG8_LDB(B1, 0, 1); PG8_SCHED; PG8_LDA(At, 0, 0); PG8_STAGE(PG8_SA(1, 1), rsA, a1, vAc[1]);
            PG8_WAIT_V(8); PG8_WAIT_L(0); PG8_BAR; PG8_MMA(0, 0, At, B0); PG8_MMA(0, 1, At, B1); PG8_BAR; PG8_SCHED;
            PG8_LDA(At, 0, 1); PG8_STAGE(PG8_SB(0, 0), rsB, b2, voffB); PG8_STAGE(PG8_SB(0, 1), rsB, b2 + (unsigned)hstep, voffB); PG8_STAGE(PG8_SA(0, 0), rsA, a2, vx0);
            PG8_WAIT_V(8); PG8_WAIT_L(0); PG8_BAR; PG8_MMA(1, 0, At, B0); PG8_MMA(1, 1, At, B1); PG8_BAR; PG8_SCHED;
            PG8_LDB(B0, 1, 0); PG8_LDB(B1, 1, 1); PG8_SCHED; PG8_LDA(At, 1, 0); PG8_STAGE(PG8_SA(0, 1), rsA, a2, vx1);
            PG8_WAIT_V(8); PG8_WAIT_L(0); PG8_BAR; PG8_MMA(0, 0, At, B0); PG8_MMA(0, 1, At, B1); PG8_BAR; PG8_SCHED;
            PG8_LDA(At, 1, 1); PG8_STAGE(PG8_SB(1, 0), rsB, b3, voffB); PG8_STAGE(PG8_SB(1, 1), rsB, b3 + (unsigned)hstep, voffB); PG8_STAGE(PG8_SA(1, 0), rsA, a3, vx0);
            PG8_WAIT_V(8); PG8_WAIT_L(0); PG8_BAR; PG8_MMA(1, 0, At, B0); PG8_MMA(1, 1, At, B1); PG8_BAR; PG8_SCHED;
        }
        if constexpr (F8) { asm volatile("s_nop 15\n\ts_nop 15" ::: "memory"); }
        if constexpr (ALIGN_EPI) { if (wr == 0) PG8_BAR; }
        if constexpr (!Epi::AFTER_DRAIN) { if constexpr (Epi::BIAS_DMA) E(acc, cur, wr, wc, fr, fq, ui); else E(acc, cur, wr, wc, fr, fq); S.done(cur); }
        if (!has_next) break;
#pragma unroll
        for (int a = 0; a < 2; ++a)
#pragma unroll
            for (int b = 0; b < 2; ++b)
#pragma unroll
                for (int m = 0; m < 4; ++m)
#pragma unroll
                    for (int n = 0; n < 2; ++n) acc[a][b][m][n] = (f32x4){0.f, 0.f, 0.f, 0.f};
        cur = nxt; cA = nA; cB = nB; ++ui;
        if constexpr (GATHER) { _Pragma("unroll") for (int h = 0; h < 2; ++h) _Pragma("unroll") for (int i = 0; i < 2; ++i) vAc[h][i] = vAn[h][i]; }
        if constexpr (ALIGN_EPI) { if (wr == 1) PG8_BAR; }
    }
    PG8_WAIT_V(0);
    if constexpr (!ALIGN_EPI) { if (wr == 0) PG8_BAR; }
    PG8_BAR;
    if constexpr (Epi::AFTER_DRAIN) { E.fused(acc, cur, wr, wc, fr, fq, lds, wid, lane); S.done(cur); }
#undef PG8_SA
#undef PG8_SB
#undef PG8_STAGE
#undef PG8_TOKDMA
#undef PG8_TOKOFF
#undef PG8_LDA
#undef PG8_LDB
#undef PG8_MMA
#undef PG8_WAIT_V
#undef PG8_WAIT_L
#undef PG8_BAR
#undef PG8_SCHED
}
}

namespace attn_body {
using bf16=__hip_bfloat16;
using bf16x8=__attribute__((ext_vector_type(8)))short;
using s16x4=__attribute__((ext_vector_type(4)))short;
using f32x16=__attribute__((ext_vector_type(16)))float;
using u32x4=__attribute__((ext_vector_type(4)))unsigned;
constexpr int D=64;
constexpr int NW=8,QBLK=32,QB=QBLK*NW,KVBLK=64;
__device__ __forceinline__ int crow(int r,int hi){return (r&3)+8*(r>>2)+4*hi;}
#define SBAR() __builtin_amdgcn_sched_barrier(0)
__device__ __forceinline__ void cmask(f32x16&p0,f32x16&p1,int jb,int qrel,int hi){
  const float NEG=-INFINITY; int kb=64*jb+4*hi;
  #pragma unroll
  for(int r=0;r<16;++r){int kv=kb+(r&3)+8*(r>>2); if(kv>qrel)p0[r]=NEG; if(kv+32>qrel)p1[r]=NEG;}
}

constexpr int NSLOT=6, SLOTB=8192;
constexpr int LDS_K=0, LDS_V=NSLOT*SLOTB, LDS_WS=2*NSLOT*SLOTB, LDS_OST=LDS_K, LDS_BYTES=LDS_WS+NW*64*4;
constexpr float C2=0.125f*1.4426950408889634f;
__device__ __forceinline__ void glds16(const void*gsrc,unsigned lds_dst){unsigned keep;
  asm volatile("s_mov_b32 %0, m0\n\ts_mov_b32 m0, %2\n\ts_nop 0\n\tglobal_load_lds_dwordx4 %1, off\n\ts_mov_b32 m0, %0":"=&s"(keep):"v"(gsrc),"s"(lds_dst):"memory");}
__device__ __forceinline__ void glds16s(unsigned long long sbase,unsigned voff,unsigned lds_dst){unsigned keep;
  asm volatile("s_mov_b32 %0, m0\n\ts_mov_b32 m0, %3\n\ts_nop 0\n\tglobal_load_lds_dwordx4 %1, %2\n\ts_mov_b32 m0, %0":"=&s"(keep):"v"(voff),"s"(sbase),"s"(lds_dst):"memory");}
__device__ __forceinline__ float max3f(float a,float b,float c){float r;asm("v_max3_f32 %0, %1, %2, %3":"=v"(r):"v"(a),"v"(b),"v"(c));return r;}
__device__ __forceinline__ float max2f(float a,float b){float r;asm("v_max_f32_e32 %0, %1, %2":"=v"(r):"v"(a),"v"(b));return r;}
__device__ __forceinline__ float fadd_s(float a,float b){float r;asm("v_add_f32_e32 %0, %1, %2":"=v"(r):"v"(a),"v"(b));return r;}
__device__ __forceinline__ float fsub_s(float a,float b){float r;asm("v_sub_f32_e32 %0, %1, %2":"=v"(r):"v"(a),"v"(b));return r;}
typedef float f32x2_t __attribute__((ext_vector_type(2))); typedef __bf16 bf16x2_t __attribute__((ext_vector_type(2)));
__device__ __forceinline__ unsigned cvtpk_s(float lo,float hi){f32x2_t v={lo,hi};bf16x2_t b=__builtin_convertvector(v,bf16x2_t);return __builtin_bit_cast(unsigned,b);}
#define WAIT_BAR(N) asm volatile("s_waitcnt vmcnt(" #N ") lgkmcnt(0)\n\ts_barrier":::"memory")

__device__ __forceinline__ void qkt(f32x16&p0,f32x16&p1,const char*Kslot,const bf16x8*qr,const f32x16&negm,int r32,int hi){
  const char*kb=Kslot+hi*1024+r32*16;
  #pragma unroll
  for(int d0=0;d0<4;++d0){
    const bf16x8 b0=*reinterpret_cast<const bf16x8*>(kb+d0*2048);
    const bf16x8 b1=*reinterpret_cast<const bf16x8*>(kb+d0*2048+512);
    if(d0==0){p0=__builtin_amdgcn_mfma_f32_32x32x16_bf16(b0,qr[0],negm,0,0,0);p1=__builtin_amdgcn_mfma_f32_32x32x16_bf16(b1,qr[0],negm,0,0,0);}
    else{p0=__builtin_amdgcn_mfma_f32_32x32x16_bf16(b0,qr[d0],p0,0,0,0);p1=__builtin_amdgcn_mfma_f32_32x32x16_bf16(b1,qr[d0],p1,0,0,0);}}
}
typedef __attribute__((address_space(3))) const char* lds_cptr;
typedef short v4i16_t __attribute__((ext_vector_type(4)));
__device__ __forceinline__ void kload8(bf16x8*kf,lds_cptr kp){
  kf[0]=*(const __attribute__((address_space(3))) bf16x8*)(kp);      kf[1]=*(const __attribute__((address_space(3))) bf16x8*)(kp+512);
  kf[2]=*(const __attribute__((address_space(3))) bf16x8*)(kp+2048); kf[3]=*(const __attribute__((address_space(3))) bf16x8*)(kp+2560);
  kf[4]=*(const __attribute__((address_space(3))) bf16x8*)(kp+4096); kf[5]=*(const __attribute__((address_space(3))) bf16x8*)(kp+4608);
  kf[6]=*(const __attribute__((address_space(3))) bf16x8*)(kp+6144); kf[7]=*(const __attribute__((address_space(3))) bf16x8*)(kp+6656);
}
__device__ __forceinline__ void kload2(bf16x8*kf,lds_cptr kp,int j){ kf[2*j]=*(const __attribute__((address_space(3))) bf16x8*)(kp+j*2048); kf[2*j+1]=*(const __attribute__((address_space(3))) bf16x8*)(kp+j*2048+512); }
__device__ __forceinline__ s16x4 vtr(lds_cptr p){ return __builtin_bit_cast(s16x4,__builtin_amdgcn_ds_read_tr16_b64_v4i16((__attribute__((address_space(3))) v4i16_t*)p)); }
__device__ __forceinline__ float rowmax(const f32x16&p0,const f32x16&p1){
  float a=max3f(p0[0],p0[1],p1[0]),b=max3f(p0[2],p0[3],p1[1]);a=max3f(a,p1[2],p1[3]);
  #pragma unroll
  for(int r=4;r<16;r+=4){a=max3f(a,p0[r],p0[r+1]);b=max3f(b,p0[r+2],p0[r+3]);a=max3f(a,p1[r],p1[r+1]);b=max3f(b,p1[r+2],p1[r+3]);}
  const float m=max2f(a,b);
  auto rr=__builtin_amdgcn_permlane32_swap(__float_as_uint(m),__float_as_uint(m),false,false);
  return max2f(__uint_as_float(rr[0]),__uint_as_float(rr[1]));
}
__device__ __forceinline__ void pv(f32x16*o,int vb,bf16x8 pa0,bf16x8 pa1,bf16x8 pa2,bf16x8 pa3){
  #pragma unroll
  for(int d0=0;d0<2;++d0){s16x4 lo[4],hi[4];
    #pragma unroll
    for(int ks=0;ks<4;++ks){
      asm volatile("ds_read_b64_tr_b16 %0,%1 offset:%c2":"=&v"(lo[ks]):"v"(vb),"i"(d0*4096+ks*1024):"memory");
      asm volatile("ds_read_b64_tr_b16 %0,%1 offset:%c2":"=&v"(hi[ks]):"v"(vb),"i"(d0*4096+ks*1024+512):"memory");}
    asm volatile("s_waitcnt lgkmcnt(0)":::"memory");SBAR();
    #define PK(k) (bf16x8){lo[k][0],lo[k][1],lo[k][2],lo[k][3],hi[k][0],hi[k][1],hi[k][2],hi[k][3]}
    o[d0]=__builtin_amdgcn_mfma_f32_32x32x16_bf16(pa0,PK(0),o[d0],0,0,0);
    o[d0]=__builtin_amdgcn_mfma_f32_32x32x16_bf16(pa1,PK(1),o[d0],0,0,0);
    o[d0]=__builtin_amdgcn_mfma_f32_32x32x16_bf16(pa2,PK(2),o[d0],0,0,0);
    o[d0]=__builtin_amdgcn_mfma_f32_32x32x16_bf16(pa3,PK(3),o[d0],0,0,0);
    #undef PK
  }
}

#ifndef ATTN_STORE16
#define ATTN_STORE16(p,v) (*(u32x4*)(p)=(v))
#endif
typedef _Float16 h2_t __attribute__((ext_vector_type(2))); typedef _Float16 h8_t __attribute__((ext_vector_type(8)));
__device__ __forceinline__ unsigned cvtpk_h(float lo,float hi){f32x2_t v={lo,hi};h2_t b=__builtin_convertvector(v,h2_t);return __builtin_bit_cast(unsigned,b);}
__device__ __forceinline__ void pvh(f32x16*o,int vb,bf16x8 pa0,bf16x8 pa1,bf16x8 pa2,bf16x8 pa3){
  #pragma unroll
  for(int d0=0;d0<2;++d0){s16x4 lo[4],hi[4];
    #pragma unroll
    for(int ks=0;ks<4;++ks){
      asm volatile("ds_read_b64_tr_b16 %0,%1 offset:%c2":"=&v"(lo[ks]):"v"(vb),"i"(d0*4096+ks*1024):"memory");
      asm volatile("ds_read_b64_tr_b16 %0,%1 offset:%c2":"=&v"(hi[ks]):"v"(vb),"i"(d0*4096+ks*1024+512):"memory");}
    asm volatile("s_waitcnt lgkmcnt(0)":::"memory");SBAR();
    #define PKH(k) __builtin_bit_cast(h8_t,(bf16x8){lo[k][0],lo[k][1],lo[k][2],lo[k][3],hi[k][0],hi[k][1],hi[k][2],hi[k][3]})
    o[d0]=__builtin_amdgcn_mfma_f32_32x32x16_f16(__builtin_bit_cast(h8_t,pa0),PKH(0),o[d0],0,0,0);
    o[d0]=__builtin_amdgcn_mfma_f32_32x32x16_f16(__builtin_bit_cast(h8_t,pa1),PKH(1),o[d0],0,0,0);
    o[d0]=__builtin_amdgcn_mfma_f32_32x32x16_f16(__builtin_bit_cast(h8_t,pa2),PKH(2),o[d0],0,0,0);
    o[d0]=__builtin_amdgcn_mfma_f32_32x32x16_f16(__builtin_bit_cast(h8_t,pa3),PKH(3),o[d0],0,0,0);
    #undef PKH
  }
}
template<bool FIXED,int THRL,int PQ,int PK,int PV,int PO,int NT> __device__ __forceinline__ void attn_unit(const bf16*Qu,const bf16*__restrict__ Kh,const bf16*__restrict__ Vh,bf16*Ou,char*shm,float mref){
  const int tid=threadIdx.x,lane=tid&63,r32=lane&31,hi=lane>>5; const int wid=__builtin_amdgcn_readfirstlane(tid>>6);

  const bf16*Qw=Qu+(long)(wid*QBLK)*PQ;

  const unsigned lds0=(unsigned)(uintptr_t)shm;
  float*wsf=(float*)(shm+LDS_WS)+wid*64;
  const unsigned kvo=(unsigned)(lane*PK+wid*8)*2u, vvo=(unsigned)((16*(wid&3)+(lane>>2))*PV+(wid>>2)*32+(lane&3)*8)*2u;
  const unsigned long long kb64=((unsigned long long)(unsigned)__builtin_amdgcn_readfirstlane((int)((unsigned long long)(uintptr_t)Kh>>32))<<32)|(unsigned)__builtin_amdgcn_readfirstlane((int)(unsigned)(uintptr_t)Kh);
  const unsigned long long vb64=((unsigned long long)(unsigned)__builtin_amdgcn_readfirstlane((int)((unsigned long long)(uintptr_t)Vh>>32))<<32)|(unsigned)__builtin_amdgcn_readfirstlane((int)(unsigned)(uintptr_t)Vh);
  const unsigned kdst=lds0+LDS_K+wid*1024, vdst=lds0+LDS_V+wid*1024;
  #define DMA_K(t,slot) glds16s(kb64+(unsigned long long)(t)*(KVBLK*PK*2),kvo,(unsigned)__builtin_amdgcn_readfirstlane(kdst+(slot)))
  #define DMA_V(t,slot) glds16s(vb64+(unsigned long long)(t)*(KVBLK*PV*2),vvo,(unsigned)__builtin_amdgcn_readfirstlane(vdst+(slot)))
  const int vb0=(int)(lds0+LDS_V)+((lane>>4)&1)*32+(lane&3)*8+(4*hi+((lane&15)>>2))*64;
  const char*Kbase=shm+LDS_K; bf16x8 kf[8];
  const lds_cptr shm3=(lds_cptr)shm; const lds_cptr kp0=shm3+LDS_K+hi*1024+r32*16; const lds_cptr vp0=shm3+LDS_V+((lane>>4)&1)*32+(lane&3)*8+(4*hi+((lane&15)>>2))*64;
  static_assert(NT>=8 && NT%2==0,"NT");
  DMA_K(0,0);DMA_V(0,0);DMA_K(1,SLOTB);
  bf16x8 qr[4];
  #pragma unroll
  for(int d0=0;d0<4;++d0)qr[d0]=*reinterpret_cast<const bf16x8*>(&Qw[(long)r32*PQ+d0*16+hi*8]);
  float mhat=0.f,l_reg=0.f;f32x16 o[2];o[0]=f32x16{};o[1]=f32x16{};f32x16 negm=f32x16{}; if constexpr(!FIXED){ asm volatile("":"+v"(negm)); } (void)mref; const f32x16 negc={-4.f,-4.f,-4.f,-4.f,-4.f,-4.f,-4.f,-4.f,-4.f,-4.f,-4.f,-4.f,-4.f,-4.f,-4.f,-4.f}; h2_t hs={(_Float16)0.f,(_Float16)0.f},hs2={(_Float16)0.f,(_Float16)0.f};
  #define QK0(C_,KF_,QR_) do{ if constexpr(FIXED){ asm volatile("v_mfma_f32_32x32x16_bf16 %0, %1, %2, -4.0":"=&v"(C_):"v"(KF_),"v"(QR_)); } else { C_=__builtin_amdgcn_mfma_f32_32x32x16_bf16(KF_,QR_,negm,0,0,0); } }while(0)
  #define NEGM (FIXED?negc:negm)
  const int qrel=wid*QBLK+r32;
  #define CMASK(P0,P1,t) do{}while(0)
  bool resc=false;
  #define START(P0,P1) do{ resc=false; if constexpr(!FIXED){ const float rm=rowmax(P0,P1); \
      const float dl=rm; mhat=fadd_s(mhat,dl); \
      _Pragma("unroll") for(int r=0;r<16;++r){P0[r]=fsub_s(P0[r],dl);P1[r]=fsub_s(P1[r],dl);} \
      _Pragma("unroll") for(int r=0;r<16;++r)negm[r]=-mhat; asm volatile("":"+v"(negm)); } \
    _Pragma("unroll") for(int r=0;r<16;++r)P0[r]=__builtin_amdgcn_exp2f(P0[r]); }while(0)
  #define RESC() do{ if constexpr(!FIXED) if(resc){ asm volatile("s_waitcnt lgkmcnt(0)":::"memory"); \
      _Pragma("unroll") for(int d_=0;d_<2;++d_) _Pragma("unroll") for(int r=0;r<16;++r)o[d_][r]*=wsf[crow(r,hi)]; } }while(0)
  f32x16 pA0,pA1,pB0,pB1;
  int s_m3=4*SLOTB,s_m1=0,s_p1=2*SLOTB;
  #define ROT1(x) x=((x)==(NSLOT-1)*SLOTB)?0:(x)+SLOTB
  #define ROT() do{ROT1(s_m3);ROT1(s_m1);ROT1(s_p1);}while(0)
  WAIT_BAR(0);
  DMA_K(2,2*SLOTB);DMA_K(3,3*SLOTB);DMA_V(1,SLOTB);DMA_K(4,4*SLOTB);DMA_K(5,5*SLOTB);DMA_V(2,2*SLOTB);DMA_V(3,3*SLOTB);
  qkt(pA0,pA1,Kbase,qr,NEGM,r32,hi);asm volatile("s_nop 15\n\ts_nop 7":"+v"(pA0),"+v"(pA1));CMASK(pA0,pA1,0);
  START(pA0,pA1);
  _Pragma("unroll") for(int r=0;r<16;++r)pA1[r]=__builtin_amdgcn_exp2f(pA1[r]);
  WAIT_BAR(4);
  kload8(kf,kp0+SLOTB);
  WAIT_BAR(4);
  s16x4 vlo[8],vhi[8]; u32x4 pw0,pw1,pw2,pw3; pw3=(u32x4){0u,0u,0u,0u};
  #define PKW(P,B) (FIXED?cvtpk_h(P[B],P[B+1]):cvtpk_s(P[B],P[B+1]))
  #define PVMF(A_,B_,C_) (FIXED?__builtin_amdgcn_mfma_f32_32x32x16_f16(__builtin_bit_cast(h8_t,A_),__builtin_bit_cast(h8_t,B_),C_,0,0,0):__builtin_amdgcn_mfma_f32_32x32x16_bf16(A_,B_,C_,0,0,0))
  #define HSUM(E_) do{ if constexpr(FIXED){ hs=hs+__builtin_bit_cast(h2_t,(unsigned)(E_)); } }while(0)
  #define HSUM2(E_) do{ if constexpr(FIXED){ hs2=hs2+__builtin_bit_cast(h2_t,(unsigned)(E_)); } }while(0)
  #define PAF(k) __builtin_bit_cast(bf16x8,pw##k)
  #define VFR(i) (bf16x8){vlo[i][0],vlo[i][1],vlo[i][2],vlo[i][3],vhi[i][0],vhi[i][1],vhi[i][2],vhi[i][3]}
  #define PIN(x) asm volatile("":"+v"(x))
  #define MX3(a,b,c) __builtin_fmaxf(__builtin_fmaxf((a),(b)),(c))
  #define PINF(PW) do{ if constexpr(FIXED){ PIN(PW); } }while(0)
  #define GAPA(MF,A0,A1,A2,A3,W0,W1,PW,HP,E0,E1,PP) do{ MF; if(HP){ PINF(PP); } if constexpr(!FIXED){ sacc+=A0; sacc+=A1; sacc+=A2; sacc+=A3; PIN(sacc); W0; W1; PIN(PW); } else { if(HP){ HSUM(E0); HSUM2(E1); } W0; W1; if(HP){ PIN(hs); PIN(hs2); } } SBAR(); }while(0)
  #define GAPA0(MF,A0,A1,A2,A3,W0,W1,PW,FL_) do{ MF; if constexpr(!FIXED){ sacc+=A0; sacc+=A1; sacc+=A2; sacc+=A3; PIN(sacc); W0; W1; PIN(PW); } else { PIN(pw3); HSUM(pw3[2]); HSUM2(pw3[3]); \
      if(FL_){ hs=hs+hs2; l_reg+=(float)hs[0]+(float)hs[1]; PIN(l_reg); hs=(h2_t){(_Float16)0.f,(_Float16)0.f}; hs2=hs; } W0; W1; PIN(hs); PIN(hs2); } SBAR(); }while(0)
  #define EX(v) __builtin_amdgcn_exp2f(v)
  #define GAPB(MF,X,B) do{ MF; X[B]=EX(X[B]); X[B+1]=EX(X[B+1]); X[B+2]=EX(X[B+2]); X[B+3]=EX(X[B+3]); PIN(X); SBAR(); }while(0)
  #define VRD(i) do{ vlo[i]=vtr(vp_+(((i)>>2)*4096+((i)&3)*1024)); vhi[i]=vtr(vp_+(((i)>>2)*4096+((i)&3)*1024+512)); }while(0)
  #define KRD(G,j) do{ if(G){ kload2(kf,kp0+s_p1,j); SBAR(); } }while(0)
  #define STEP(C0,C1,P0,P1,t,GK,GV,GL,FL) do{ SBAR(); \
    const lds_cptr vp_=vp0+s_m1; \
    VRD(0); SBAR(); float sacc=0.f; if constexpr(!FIXED){ sacc=(P0[0]+P0[1]); } \
    GAPA0(QK0(C0,kf[0],qr[0]), P0[2],P0[3],P0[4],P0[5],     pw0[0]=PKW(P0,0), pw0[1]=PKW(P0,2), pw0, FL); \
    VRD(4); SBAR(); GAPA(QK0(C1,kf[1],qr[0]), P0[6],P0[7],P0[8],P0[9],     pw0[2]=PKW(P0,4), pw0[3]=PKW(P0,6), pw0, true, pw0[0], pw0[1], pw0); \
    VRD(1); SBAR(); GAPA(C0=__builtin_amdgcn_mfma_f32_32x32x16_bf16(kf[2],qr[1],C0,0,0,0),   P0[10],P0[11],P0[12],P0[13], pw1[0]=PKW(P0,8), pw1[1]=PKW(P0,10), pw1, true, pw0[2], pw0[3], pw0); \
    if(GK){DMA_K((t)+5,s_m1);} SBAR(); VRD(5); SBAR(); GAPA(C1=__builtin_amdgcn_mfma_f32_32x32x16_bf16(kf[3],qr[1],C1,0,0,0),   P0[14],P0[15],P1[0],P1[1],   pw1[2]=PKW(P0,12), pw1[3]=PKW(P0,14), pw1, true, pw1[0], pw1[1], pw1); \
    VRD(2); SBAR(); GAPA(C0=__builtin_amdgcn_mfma_f32_32x32x16_bf16(kf[4],qr[2],C0,0,0,0),   P1[2],P1[3],P1[4],P1[5],     pw2[0]=PKW(P1,0), pw2[1]=PKW(P1,2), pw2, true, pw1[2], pw1[3], pw1); \
    if(GV){DMA_V((t)+3,s_m3);} SBAR(); VRD(6); SBAR(); GAPA(C1=__builtin_amdgcn_mfma_f32_32x32x16_bf16(kf[5],qr[2],C1,0,0,0),   P1[6],P1[7],P1[8],P1[9],     pw2[2]=PKW(P1,4), pw2[3]=PKW(P1,6), pw2, true, pw2[0], pw2[1], pw2); \
    VRD(3); SBAR(); GAPA(C0=__builtin_amdgcn_mfma_f32_32x32x16_bf16(kf[6],qr[3],C0,0,0,0),   P1[10],P1[11],P1[12],P1[13], pw3[0]=PKW(P1,8), pw3[1]=PKW(P1,10), pw3, true, pw2[2], pw2[3], pw2); \
    VRD(7); SBAR(); GAPA(C1=__builtin_amdgcn_mfma_f32_32x32x16_bf16(kf[7],qr[3],C1,0,0,0),   P1[14],P1[15],0.f,0.f,       pw3[2]=PKW(P1,12), pw3[3]=PKW(P1,14), pw3, true, pw3[0], pw3[1], pw3); \
    if constexpr(!FIXED){ l_reg+=sacc; } \
    CMASK(C0,C1,t); \
    if constexpr(!FIXED){ float a=MX3(C0[0],C0[1],C1[0]),b=MX3(C0[2],C0[3],C1[1]); a=MX3(a,C1[2],C1[3]); \
      _Pragma("unroll") for(int r=4;r<16;r+=4){a=MX3(a,C0[r],C0[r+1]);b=MX3(b,C0[r+2],C0[r+3]);a=MX3(a,C1[r],C1[r+1]);b=MX3(b,C1[r+2],C1[r+3]);} \
      float rm=__builtin_fmaxf(a,b); { auto rr=__builtin_amdgcn_permlane32_swap(__float_as_uint(rm),__float_as_uint(rm),false,false); rm=__builtin_fmaxf(__uint_as_float(rr[0]),__uint_as_float(rr[1])); } \
      resc=false; \
      if(__builtin_expect(__any(rm>(float)THRL),0)){ const float dl=__builtin_fmaxf(rm,0.f); mhat+=dl; \
        _Pragma("unroll") for(int r=0;r<16;++r){C0[r]-=dl;C1[r]-=dl;} \
        _Pragma("unroll") for(int r=0;r<16;++r)negm[r]=-mhat; asm volatile("":"+v"(negm)); \
        const float f=__builtin_amdgcn_exp2f(-dl); l_reg*=f; if(hi==0)wsf[r32]=f; resc=true; } } \
    SBAR(); \
    GAPB(o[0]=PVMF(PAF(0),VFR(0),o[0]), C0,0); \
    GAPB(o[1]=PVMF(PAF(0),VFR(4),o[1]), C0,4); \
    KRD(GL,0); GAPB(o[0]=PVMF(PAF(1),VFR(1),o[0]), C0,8); \
    KRD(GL,1); GAPB(o[1]=PVMF(PAF(1),VFR(5),o[1]), C0,12); \
    KRD(GL,2); GAPB(o[0]=PVMF(PAF(2),VFR(2),o[0]), C1,0); \
    KRD(GL,3); GAPB(o[1]=PVMF(PAF(2),VFR(6),o[1]), C1,4); \
    GAPB(o[0]=PVMF(PAF(3),VFR(3),o[0]), C1,8); \
    GAPB(o[1]=PVMF(PAF(3),VFR(7),o[1]), C1,12); \
    }while(0)
  int t=1;
  #undef CMASK
  #define CMASK(P0,P1,t) do{}while(0)
  for(;t+7<NT;t+=2){
    STEP(pB0,pB1,pA0,pA1,t,true,true,true,true);     RESC(); ROT();
    STEP(pA0,pA1,pB0,pB1,t+1,true,true,true,false);   WAIT_BAR(4); RESC(); ROT();
  }
  #undef CMASK
  #define CMASK(P0,P1,t) do{}while(0)
  #define ENDW(tt) do{ if((tt)+6<NT){WAIT_BAR(4);} else if((tt)+4<NT){WAIT_BAR(2);} else {WAIT_BAR(0);} }while(0)
  for(;t+1<NT;t+=2){
    STEP(pB0,pB1,pA0,pA1,t,(t+5<NT),(t+3<NT),(t+1<NT),true);       RESC(); ROT();
    STEP(pA0,pA1,pB0,pB1,t+1,(t+6<NT),(t+4<NT),(t+2<NT),false);     ENDW(t); RESC(); ROT();
  }
  STEP(pB0,pB1,pA0,pA1,NT-1,false,false,false,true); RESC();
  { if constexpr(!FIXED){ float sacc=pB0[0]+pB0[1]; _Pragma("unroll") for(int r=2;r<16;++r)sacc+=pB0[r]; _Pragma("unroll") for(int r=0;r<16;++r)sacc+=pB1[r]; l_reg+=sacc; }
    if constexpr(FIXED){ HSUM(pw3[2]); HSUM2(pw3[3]); }
    pw0=(u32x4){PKW(pB0,0),PKW(pB0,2),PKW(pB0,4),PKW(pB0,6)};pw1=(u32x4){PKW(pB0,8),PKW(pB0,10),PKW(pB0,12),PKW(pB0,14)};pw2=(u32x4){PKW(pB1,0),PKW(pB1,2),PKW(pB1,4),PKW(pB1,6)};pw3=(u32x4){PKW(pB1,8),PKW(pB1,10),PKW(pB1,12),PKW(pB1,14)};
    if constexpr(FIXED){ _Pragma("unroll") for(int q_=0;q_<4;++q_){ HSUM(pw0[q_]); HSUM2(pw1[q_]); HSUM(pw2[q_]); HSUM2(pw3[q_]); } hs=hs+hs2; l_reg+=(float)hs[0]+(float)hs[1]; }
    const int sl_last=(s_m1==(NSLOT-1)*SLOTB)?0:s_m1+SLOTB;
    SBAR(); if constexpr(FIXED) pvh(o,vb0+sl_last,PAF(0),PAF(1),PAF(2),PAF(3)); else pv(o,vb0+sl_last,PAF(0),PAF(1),PAF(2),PAF(3)); }
  #undef PKW
  #undef PVMF
  #undef HSUM
  #undef HSUM2
  #undef PAF
  #undef VFR
  #undef PIN
  #undef MX3
  #undef GAPA
  #undef GAPA0
  #undef PINF
  #undef GAPB
  #undef EX
  #undef VRD
  #undef KRD
  #undef STEP
  #undef ENDW
  {auto rr=__builtin_amdgcn_permlane32_swap(__float_as_uint(l_reg),__float_as_uint(l_reg),false,false);l_reg=__uint_as_float(rr[0])+__uint_as_float(rr[1]);}
  if(hi==0)wsf[32+r32]=l_reg;asm volatile("s_waitcnt lgkmcnt(0)":::"memory");
  float rli[16];
  #pragma unroll
  for(int r=0;r<16;++r)rli[r]=__builtin_amdgcn_rcpf(wsf[32+crow(r,hi)]);
  bf16*Ow=Ou+(long)(wid*QBLK)*PO;
  { bf16*stg=(bf16*)(shm+LDS_OST)+wid*2048;
    #pragma unroll
    for(int r=0;r<16;++r){const int orow=crow(r,hi);
      #pragma unroll
      for(int d0=0;d0<2;++d0)stg[orow*64+d0*32+r32]=__float2bfloat16(o[d0][r]*rli[r]);}
    asm volatile("s_waitcnt lgkmcnt(0)":::"memory");
    #pragma unroll
    for(int i=0;i<4;++i){const int row=i*8+(lane>>3),ch=lane&7; const u32x4 v=*(const u32x4*)(stg+row*64+ch*8); ATTN_STORE16(Ow+(long)row*PO+ch*8,v);} }
  asm volatile("s_waitcnt lgkmcnt(0)\n\ts_barrier":::"memory");
  #undef DMA_K
  #undef DMA_V
  #undef CMASK
  #undef START
  #undef NEGM
  #undef QK0
  #undef RESC
  #undef ROT
  #undef ROT1
}

constexpr int SEQ_=16384, INW_=6912, MTOK_=2*SEQ_;
constexpr int B_LDS_K=0, B_LDS_V=49152, B_LDS_WS=98304, B_LDS_BYTES=98304+2048;
__device__ __forceinline__ void attnb_phase(int u0,int ustep,const bf16*P,bf16*Ob,float*Lse,char*shm,unsigned*qhead){
  int tid_=threadIdx.x; asm volatile("":"+v"(tid_));
  const int tid=tid_,lane=tid&63,r32=lane&31,hi=lane>>5; const int wid=__builtin_amdgcn_readfirstlane(tid>>6);
  const unsigned lds0=(unsigned)(uintptr_t)shm;
  float*wsf=(float*)(shm+B_LDS_WS)+wid*64;
  const float C2=0.125f*1.4426950408889634f;
  const int jt0=wid>>1;
  const float ltf=(float)(4*hi-r32-32*(wid&1)-64);
  const int vb0=(int)(lds0+B_LDS_V)+((lane>>4)&1)*32+(lane&3)*8+(4*hi+((lane&15)>>2))*64;
  #define BDEC(u_,b_,g_,h_,dil_,r_,qb_) do{ g_=(u_)>>10; const int rem_=(u_)&1023; b_=rem_>>9; h_=(rem_>>6)&7; const int rq_=rem_&63, dsh_=2*g_; dil_=1<<dsh_; r_=rq_>>(6-dsh_); qb_=rq_&((64>>dsh_)-1); }while(0)
  #define BBASE(kind_,b_,g_,h_,dil_,r_) (P+((size_t)(((((g_)*3+(kind_))*2+(b_))*8+(h_)))<<20)+(size_t)(r_)*(SEQ_/(dil_))*64)
  #define BDMA_K(b_,g_,h_,dil_,r_,qb_) do{ int ln_=lane; asm volatile("":"+v"(ln_)); const int L_=SEQ_/(dil_); const bf16*Pb_=BBASE(1,b_,g_,h_,dil_,r_); const int kb_=(qb_)*256-64; \
      _Pragma("unroll") for(int j=0;j<6;++j){ int ik=kb_+64*j+ln_; ik=ik<0?0:(ik>=L_?L_-1:ik); \
        glds16(Pb_+(size_t)ik*64+wid*8,(unsigned)__builtin_amdgcn_readfirstlane(lds0+B_LDS_K+j*8192+wid*1024)); } }while(0)
  #define BDMA_V(b_,g_,h_,dil_,r_,qb_) do{ int ln_=lane; asm volatile("":"+v"(ln_)); const int L_=SEQ_/(dil_); const bf16*Pb_=BBASE(2,b_,g_,h_,dil_,r_); const int kb_=(qb_)*256-64; \
      _Pragma("unroll") for(int j=0;j<6;++j){ int iv=kb_+64*j+16*(wid&3)+(ln_>>2); iv=iv<0?0:(iv>=L_?L_-1:iv); \
        glds16(Pb_+(size_t)iv*64+(wid>>2)*32+(ln_&3)*8,(unsigned)__builtin_amdgcn_readfirstlane(lds0+B_LDS_V+j*8192+wid*1024)); } }while(0)
  #define BLOAD_Q(Q_,b_,g_,h_,dil_,r_,qb_) do{ int ln_=lane; asm volatile("":"+v"(ln_)); const bf16*qp_=BBASE(0,b_,g_,h_,dil_,r_)+(size_t)((qb_)*256+wid*32+(ln_&31))*64+(ln_>>5)*8; \
      _Pragma("unroll") for(int d0=0;d0<4;++d0)Q_[d0]=*reinterpret_cast<const bf16x8*>(qp_+d0*16); }while(0)
  int u=u0; if(u>=3072)return;
  int*nxw=(int*)(shm+B_LDS_WS);
  if(tid==0){ const unsigned t_=__hip_atomic_fetch_add(qhead,1u,__ATOMIC_RELAXED,__HIP_MEMORY_SCOPE_AGENT); *nxw=ustep+(int)t_; }
  int b,g,h,dil,r,qb; BDEC(u,b,g,h,dil,r,qb);
  bf16x8 qn[4];
  BDMA_K(b,g,h,dil,r,qb); BLOAD_Q(qn,b,g,h,dil,r,qb);
  for(;;){
    asm volatile("":"+v"(qn[0]),"+v"(qn[1]),"+v"(qn[2]),"+v"(qn[3]));
    asm volatile("s_waitcnt vmcnt(0)\n\ts_barrier":::"memory");
    BDMA_V(b,g,h,dil,r,qb);
    const int L=SEQ_/dil, kb_i=qb*256-64, iq=qb*256+wid*32+r32;
    f32x16 s0a,s0b,s1a,s1b,s2a,s2b; const f32x16 zz=f32x16{};
    qkt(s0a,s0b,shm+B_LDS_K+(jt0+0)*8192,qn,zz,r32,hi);
    qkt(s1a,s1b,shm+B_LDS_K+(jt0+1)*8192,qn,zz,r32,hi);
    qkt(s2a,s2b,shm+B_LDS_K+(jt0+2)*8192,qn,zz,r32,hi);
    asm volatile("s_waitcnt lgkmcnt(0)\n\ts_barrier":::"memory");
    const int un=__builtin_amdgcn_readfirstlane(*nxw); const bool has_next=un<3072;
    unsigned tk_=0u; if(tid==0&&has_next){ tk_=__hip_atomic_fetch_add(qhead,1u,__ATOMIC_RELAXED,__HIP_MEMORY_SCOPE_AGENT); }
    int nb=b,ng=g,nh=h,ndil=dil,nr=r,nqb=qb;
    if(has_next){ BDEC(un,nb,ng,nh,ndil,nr,nqb); BDMA_K(nb,ng,nh,ndil,nr,nqb); BLOAD_Q(qn,nb,ng,nh,ndil,nr,nqb); }
    const float slope2=__builtin_ldexpf(1.4426950408889634f*(float)dil,-(h+1));
    float mx=-INFINITY;
    float lt=ltf; asm volatile("":"+v"(lt));
    if(kb_i>=0&&kb_i+384<=L){
      #define BMASKF(S0,S1,tt) do{ _Pragma("unroll") for(int rr=0;rr<16;++rr){ \
          { const float t_=lt+(float)(64*(tt)+(rr&3)+8*(rr>>2)); const float v_=__builtin_fmaf(S0[rr],C2,-slope2*__builtin_fabsf(t_)); S0[rr]=(__builtin_fabsf(t_)<=64.0f)?v_:-INFINITY; mx=__builtin_fmaxf(mx,S0[rr]); } \
          { const float t_=lt+(float)(64*(tt)+(rr&3)+8*(rr>>2)+32); const float v_=__builtin_fmaf(S1[rr],C2,-slope2*__builtin_fabsf(t_)); S1[rr]=(__builtin_fabsf(t_)<=64.0f)?v_:-INFINITY; mx=__builtin_fmaxf(mx,S1[rr]); } } }while(0)
      BMASKF(s0a,s0b,0); BMASKF(s1a,s1b,1); BMASKF(s2a,s2b,2);
      #undef BMASKF
    } else {
      #define BMASK(S0,S1,tt) do{ _Pragma("unroll") for(int rr=0;rr<16;++rr){ const int ik0=kb_i+64*(jt0+(tt))+crow(rr,hi); \
          { const int jj=ik0-iq; const int aj=jj<0?-jj:jj; const bool ok=(aj<=64)&&(ik0>=0)&&(ik0<L); S0[rr]=ok?(S0[rr]*C2-slope2*(float)aj):-INFINITY; mx=__builtin_fmaxf(mx,S0[rr]); } \
          { const int ik1=ik0+32; const int jj=ik1-iq; const int aj=jj<0?-jj:jj; const bool ok=(aj<=64)&&(ik1>=0)&&(ik1<L); S1[rr]=ok?(S1[rr]*C2-slope2*(float)aj):-INFINITY; mx=__builtin_fmaxf(mx,S1[rr]); } } }while(0)
      BMASK(s0a,s0b,0); BMASK(s1a,s1b,1); BMASK(s2a,s2b,2);
      #undef BMASK
    }
    { auto rr=__builtin_amdgcn_permlane32_swap(__float_as_uint(mx),__float_as_uint(mx),false,false); mx=__builtin_fmaxf(__uint_as_float(rr[0]),__uint_as_float(rr[1])); }
    float l=0.f;
    #define BEXP(S) do{ _Pragma("unroll") for(int rr=0;rr<16;++rr){ S[rr]=__builtin_amdgcn_exp2f(S[rr]-mx); l+=S[rr]; } }while(0)
    BEXP(s0a);BEXP(s0b);BEXP(s1a);BEXP(s1b);BEXP(s2a);BEXP(s2b);
    #undef BEXP
    { auto rr=__builtin_amdgcn_permlane32_swap(__float_as_uint(l),__float_as_uint(l),false,false); l=__uint_as_float(rr[0])+__uint_as_float(rr[1]); }
    if(has_next){ asm volatile("s_waitcnt vmcnt(10)\n\ts_barrier":::"memory"); } else { asm volatile("s_waitcnt vmcnt(0)\n\ts_barrier":::"memory"); }
    if(tid==0&&has_next){ *nxw=ustep+(int)tk_; }
    f32x16 o[2]; o[0]=f32x16{}; o[1]=f32x16{};
    #define PKW(P_,B_) cvtpk_s(P_[B_],P_[B_+1])
    #define BPV(SA,SB,tt) do{ u32x4 w0=(u32x4){PKW(SA,0),PKW(SA,2),PKW(SA,4),PKW(SA,6)},w1=(u32x4){PKW(SA,8),PKW(SA,10),PKW(SA,12),PKW(SA,14)},w2=(u32x4){PKW(SB,0),PKW(SB,2),PKW(SB,4),PKW(SB,6)},w3=(u32x4){PKW(SB,8),PKW(SB,10),PKW(SB,12),PKW(SB,14)}; \
        pv(o,vb0+(jt0+(tt))*8192,__builtin_bit_cast(bf16x8,w0),__builtin_bit_cast(bf16x8,w1),__builtin_bit_cast(bf16x8,w2),__builtin_bit_cast(bf16x8,w3)); }while(0)
    BPV(s0a,s0b,0); BPV(s1a,s1b,1); BPV(s2a,s2b,2);
    #undef BPV
    #undef PKW
    { int rl_=r32; asm volatile("":"+v"(rl_)); if(hi==0)wsf[32+rl_]=l; }
    asm volatile("s_waitcnt lgkmcnt(0)\n\ts_barrier":::"memory");
    float rli[16];
    #pragma unroll
    for(int rr=0;rr<16;++rr)rli[rr]=__builtin_amdgcn_rcpf(wsf[32+crow(rr,hi)]);
    const size_t orow0=(size_t)g*MTOK_+(size_t)b*SEQ_;
    { bf16*stg=(bf16*)(shm+B_LDS_V)+wid*2048;
      #pragma unroll
      for(int rr=0;rr<16;++rr){const int orow=crow(rr,hi);
        #pragma unroll
        for(int d0=0;d0<2;++d0)stg[orow*64+d0*32+r32]=__float2bfloat16(o[d0][rr]*rli[rr]);}
      asm volatile("s_waitcnt lgkmcnt(0)":::"memory");
      #pragma unroll
      for(int i=0;i<4;++i){const int row=i*8+(lane>>3),ch=lane&7; const u32x4 v=*(const u32x4*)(stg+row*64+ch*8);
        const int tok=r+dil*(qb*256+wid*32+row); *(u32x4*)(Ob+(orow0+tok)*512+h*64+ch*8)=v;} }
    if(hi==0){ const int tok=r+dil*iq; Lse[(orow0+tok)*8+h]=mx+__builtin_amdgcn_logf(l); }
    asm volatile("s_waitcnt lgkmcnt(0)":::"memory");
    if(!has_next)break;
    u=un; b=nb; g=ng; h=nh; dil=ndil; r=nr; qb=nqb;
  }
  asm volatile("s_waitcnt vmcnt(0) lgkmcnt(0)\n\ts_barrier":::"memory");
  #undef BDEC
  #undef BBASE
  #undef BDMA_K
  #undef BDMA_V
  #undef BLOAD_Q
}
#undef SBAR
#undef WAIT_BAR
}

constexpr int NWAVES = 8;
constexpr int BATCH = 2, SEQ = 16384, DM = 2048, MTOK = BATCH * SEQ;
constexpr int AQW = 1536, AKVW = 384, INW = 6912, BW = 512;
constexpr int NE = 32, TOPK = 4;
constexpr int CAP_ROWS = MTOK * TOPK + NE * 256;
constexpr float NORM_EPS = 1e-5f, QK_EPS = 1e-6f;
constexpr int N_PHASES = 11;

constexpr size_t MiB = 1u << 20;
constexpr size_t WS_CTL = 0, CTL_ZERO_BYTES = 128 * 1024;
constexpr size_t WS_ROPE = 1 * MiB;
constexpr size_t WS_WRT  = 2 * MiB;
constexpr size_t WS_WIN  = 3 * MiB;
constexpr size_t WS_WOUT = 30 * MiB;
constexpr size_t WS_WGU  = 38 * MiB;
constexpr size_t WS_WD   = 550 * MiB;
constexpr size_t WS_HN   = 806 * MiB;
constexpr size_t WS_P    = 934 * MiB;
constexpr size_t WS_QN   = 1366 * MiB;
constexpr size_t WS_KN   = 1462 * MiB;
constexpr size_t WS_OA   = 1486 * MiB;
constexpr size_t WS_OB   = 1582 * MiB;
constexpr size_t WS_LSE  = 1678 * MiB;
constexpr size_t WS_MG   = 1682 * MiB;
constexpr size_t WS_X1   = 1810 * MiB;
constexpr size_t WS_EIDX = 2066 * MiB;
constexpr size_t WS_RANK = 2067 * MiB;
constexpr size_t WS_GATE = 2068 * MiB;
constexpr size_t WS_XG   = 2070 * MiB;
constexpr size_t WS_H    = 2614 * MiB;
constexpr size_t WS_VN   = 3158 * MiB;
constexpr size_t WS_TOKOF = 3182 * MiB;
constexpr size_t WS_END  = 3186 * MiB;
static_assert(WS_XG + (size_t)CAP_ROWS * 2048 * 2 <= WS_H && WS_H + (size_t)CAP_ROWS * 2048 * 2 <= WS_VN, "ws map");
constexpr int CW_TMO = 0, CW_CODE = 1;
constexpr int CW_BAR = 4096;
constexpr int CW_CNT = 16384;
constexpr int CW_Q8 = 16384 + 160, CW_Q9 = 16384 + 192, CW_Q1 = 16384 + 224, CW_Q5 = 16384 + 256;
constexpr int CW_QB = 16384 + 128;
constexpr int CW_VMAX = 16384 + 64;

constexpr int RING_OFF = 0, RING_BYTES = 131072;
constexpr int LDSCTL_OFF = RING_BYTES, MISC_OFF = LDSCTL_OFF + 320;
constexpr int TBL_OFF = 131584;
constexpr int PP_OFF = 134144;
constexpr int QW_OFF = 134304;
constexpr int CNT_OFF = 134400;
constexpr int ROUTE_OFF = 134656;
constexpr int LOGIT_OFF = 138752;
constexpr int LDS_BYTES = 147456;
static_assert(LOGIT_OFF + 32 * 33 * 4 <= LDS_BYTES, "LDS map");

#define GAS __attribute__((address_space(1)))
#define LAS __attribute__((address_space(3)))
typedef unsigned short bf16;
typedef unsigned v4u __attribute__((ext_vector_type(4)));
typedef unsigned v2u __attribute__((ext_vector_type(2)));
typedef float f32x4 __attribute__((ext_vector_type(4)));
typedef float f32x2 __attribute__((ext_vector_type(2)));
typedef float f32x16 __attribute__((ext_vector_type(16)));
typedef short bf16x8 __attribute__((ext_vector_type(8)));
typedef GAS unsigned gu32;
#define RLX_AGENT __ATOMIC_RELAXED, __HIP_MEMORY_SCOPE_AGENT
__device__ __forceinline__ unsigned pk2(float lo, float hi) { typedef __bf16 b2 __attribute__((ext_vector_type(2))); f32x2 v = {lo, hi}; b2 b = __builtin_convertvector(v, b2); return __builtin_bit_cast(unsigned, b); }
__device__ __forceinline__ float bflo(unsigned u) { return __builtin_bit_cast(float, u << 16); }
__device__ __forceinline__ float bfhi(unsigned u) { return __builtin_bit_cast(float, u & 0xffff0000u); }
__device__ __forceinline__ float wave_sum(float v) {
#pragma unroll
    for (int o = 1; o < 64; o <<= 1) v += __shfl_xor(v, o);
    return v;
}

#define XB_TMO      128
#define XB_XCNT(j)  (256  + 64 * (j))
#define XB_XSUB(j)  (1280 + 64 * (j))
#define XB_XGEN(j)  (2304 + 64 * (j))
#define XB_TOP      3328
#define XB_TOPGEN   3392
#define XCD_BAR_WORDS 3456
#define XB_SPIN_CAP (1u << 18)

__device__ __forceinline__ unsigned xb_ld(unsigned* p)              { return __hip_atomic_load(p, __ATOMIC_RELAXED, __HIP_MEMORY_SCOPE_AGENT); }
__device__ __forceinline__ unsigned xb_add(unsigned* p, unsigned v) { return __hip_atomic_fetch_add(p, v, __ATOMIC_RELAXED, __HIP_MEMORY_SCOPE_AGENT); }
__device__ __forceinline__ unsigned xb_xcc_id() { return (unsigned)__builtin_amdgcn_s_getreg((3 << 11) | 20) & 0xFu; }
#define XB_SPIN(cond, bar) do { unsigned _sp = 0; while (cond) { __builtin_amdgcn_s_sleep(1); \
    if ((++_sp & 255u) == 0u) { if (xb_ld(&(bar)[XB_TMO])) break; if (_sp > XB_SPIN_CAP) { atomicAdd(&(bar)[XB_TMO], 1u); break; } } } } while (0)

struct XcdBarrier {
    unsigned* bar; unsigned x;
    volatile LAS unsigned* st;
};

__device__ __forceinline__ XcdBarrier xcd_barrier_post(unsigned* bar, volatile LAS unsigned* st) {
    XcdBarrier b; b.bar = bar; b.x = xb_xcc_id(); b.st = st;
    if (threadIdx.x == 0) (void)xb_add(&bar[XB_XCNT(b.x)], 1u);
    return b;
}
__device__ __forceinline__ void xcd_barrier_complete(unsigned* bar, unsigned x, unsigned& nloc, unsigned& nx) {
    const unsigned G = gridDim.x * gridDim.y * gridDim.z;
    unsigned sum, cnt, mine, sp = 0u;
    for (;;) {
        sum = 0u; cnt = 0u; mine = 0u;
#pragma unroll
        for (unsigned j = 0; j < 16; ++j) { const unsigned c = xb_ld(&bar[XB_XCNT(j)]); sum += c; cnt += (c > 0u) ? 1u : 0u; mine = (j == x) ? c : mine; }
        if (sum == G) break;
        __builtin_amdgcn_s_sleep(1);
        if ((++sp & 255u) == 0u) { if (xb_ld(&bar[XB_TMO])) break; if (sp > XB_SPIN_CAP) { atomicAdd(&bar[XB_TMO], 1u); break; } }
    }
    nloc = mine > 0u ? mine : 1u; nx = cnt > 0u ? cnt : 1u;
}

__device__ __forceinline__ void xcd_barrier(const XcdBarrier& b) {
    asm volatile("s_waitcnt vmcnt(0)" ::: "memory");
    __syncthreads();
    if (threadIdx.x == 0) {
        unsigned* bar = b.bar;
        __builtin_amdgcn_s_waitcnt(0);
        unsigned nloc = b.st[0], nx = b.st[1];
        if (nloc == 0u) { xcd_barrier_complete(bar, b.x, nloc, nx); b.st[0] = nloc; b.st[1] = nx; }
        const unsigned old = xb_add(&bar[XB_XSUB(b.x)], 1u);
        const unsigned gen = old / nloc;
        if (old + 1u == (gen + 1u) * nloc) {
            __builtin_amdgcn_fence(__ATOMIC_RELEASE, "agent");
            asm volatile("s_waitcnt vmcnt(0)" ::: "memory");
            const unsigned og = xb_add(&bar[XB_TOP], 1u);
            const unsigned tg = og / nx;
            if (og + 1u == (tg + 1u) * nx) xb_add(&bar[XB_TOPGEN], 1u);
            else XB_SPIN(xb_ld(&bar[XB_TOPGEN]) == tg, bar);
            __builtin_amdgcn_fence(__ATOMIC_ACQUIRE, "agent");
            xb_add(&bar[XB_XGEN(b.x)], 1u);
            asm volatile("s_waitcnt vmcnt(0)" ::: "memory");
        } else {
            XB_SPIN(xb_ld(&bar[XB_XGEN(b.x)]) == gen, bar);
            __builtin_amdgcn_fence(__ATOMIC_ACQUIRE, "agent");
            asm volatile("s_waitcnt vmcnt(0)" ::: "memory");
        }
    }
    __syncthreads();
}

namespace pg8 {
struct EpiInProjA {
    static constexpr bool PERM = true, AFTER_DRAIN = false, BIAS_DMA = false;
    unsigned char* ws; const float* qnw; const float* knw; const PG8_LAS float* ropeC;
    __device__ __forceinline__ void operator()(const f32x4 (&acc)[2][2][4][2], const Unit& u, int wr, int wc, int fr_in, int fq_in) const {
        int fr = fr_in, fq = fq_in; asm volatile("" : "+v"(fr), "+v"(fq));
        bf16_t* Qn = (bf16_t*)(ws + WS_QN); bf16_t* Kn = (bf16_t*)(ws + WS_KN); unsigned short* Vh = (unsigned short*)(ws + WS_VN); bf16_t* Pv = (bf16_t*)(ws + WS_P);
        const float* rope = (const float*)(ws + WS_ROPE); unsigned* vmax = (unsigned*)(ws + WS_CTL) + CW_VMAX;
        typedef _Float16 h2e __attribute__((ext_vector_type(2))); typedef float f2e __attribute__((ext_vector_type(2)));
        const int hg = 4 * u.pn + wc;
        const int row0 = u.pm * BM + wr * 64 + fr, sb = (u.pm * BM) & 16383;
        if (hg >= 30) {
            unsigned vm = 0u;
#pragma unroll
            for (int ai = 0; ai < 2; ++ai)
#pragma unroll
                for (int m = 0; m < 4; ++m) { const size_t row = (size_t)(row0 + ai * HALF + m * 16);
#pragma unroll
                    for (int bj = 0; bj < 2; ++bj) { const f32x4 v0 = acc[ai][bj][m][0], v1 = acc[ai][bj][m][1]; const int d = 32 * bj + 8 * fq;
                        u32x4 w; w.x = cvt_pk_bf16(v0[0], v0[1]); w.y = cvt_pk_bf16(v0[2], v0[3]); w.z = cvt_pk_bf16(v1[0], v1[1]); w.w = cvt_pk_bf16(v1[2], v1[3]);
                        *(u32x4*)(Pv + row * 2304 + hg * 64 + d) = w;
                        const unsigned ww[4] = {w.x, w.y, w.z, w.w};
#pragma unroll
                        for (int i = 0; i < 4; ++i) { const unsigned lo = ww[i] & 0x7fffu, hi = (ww[i] >> 16) & 0x7fffu; vm = vm > lo ? vm : lo; vm = vm > hi ? vm : hi; }
                        u32x4 h; { f2e t = {v0[0], v0[1]}; h.x = __builtin_bit_cast(unsigned, __builtin_convertvector(t, h2e)); } { f2e t = {v0[2], v0[3]}; h.y = __builtin_bit_cast(unsigned, __builtin_convertvector(t, h2e)); }
                        { f2e t = {v1[0], v1[1]}; h.z = __builtin_bit_cast(unsigned, __builtin_convertvector(t, h2e)); } { f2e t = {v1[2], v1[3]}; h.w = __builtin_bit_cast(unsigned, __builtin_convertvector(t, h2e)); }
                        *(u32x4*)(Vh + row * 384 + (hg - 30) * 64 + d) = h; } }
#pragma unroll
            for (int o = 1; o < 64; o <<= 1) { const unsigned t = (unsigned)__shfl_xor((int)vm, o); vm = vm > t ? vm : t; }
            if ((fr | fq) == 0) atomicMax(vmax, vm);
        } else {
            const bool isq = hg < 24; const float* nw = isq ? qnw : knw; const float sc = isq ? 0.125f * 1.4426950408889634f : 1.0f;
            const bool isx1 = fq < 2; const int i16b = 8 * (fq & 1);
            f32x4 wv[2][2];
#pragma unroll
            for (int bj = 0; bj < 2; ++bj)
#pragma unroll
                for (int n = 0; n < 2; ++n) wv[bj][n] = *(const f32x4*)(nw + 32 * bj + 8 * fq + 4 * n);
            bf16_t* obase = isq ? (Qn + hg * 64) : (Kn + (hg - 24) * 64); const int opitch = isq ? 1536 : 384;
#pragma unroll
            for (int ai = 0; ai < 2; ++ai) {
                const int pos_r = (sb + ai * HALF + wr * 64) >> 6;
                f32x4 er[4];
#pragma unroll
                for (int q = 0; q < 4; ++q) er[q] = *(const f32x4*)(rope + 2 * (pos_r * 16 + i16b) + 4 * q);
#pragma unroll
                for (int m = 0; m < 4; ++m) {
                    const int pos_c = 16 * m + fr; f32x4 ec[4];
#pragma unroll
                    for (int q = 0; q < 4; ++q) ec[q] = *(const PG8_LAS f32x4*)(ropeC + 2 * (pos_c * 16 + i16b) + 4 * q);
                    float ss = 0.f;
#pragma unroll
                    for (int bj = 0; bj < 2; ++bj)
#pragma unroll
                        for (int n = 0; n < 2; ++n) { const f32x4 x = acc[ai][bj][m][n]; ss += (x[0] * x[0] + x[1] * x[1]) + (x[2] * x[2] + x[3] * x[3]); }
                    { auto r16 = __builtin_amdgcn_permlane16_swap(__float_as_uint(ss), __float_as_uint(ss), false, false); ss = __uint_as_float(r16[0]) + __uint_as_float(r16[1]); }
                    { auto r32 = __builtin_amdgcn_permlane32_swap(__float_as_uint(ss), __float_as_uint(ss), false, false); ss = __uint_as_float(r32[0]) + __uint_as_float(r32[1]); }
                    const float rstd = __builtin_amdgcn_rsqf(ss * (1.f / 64.f) + 1e-6f);
                    const size_t row = (size_t)(row0 + ai * HALF + m * 16);
#pragma unroll
                    for (int bj = 0; bj < 2; ++bj) { float ov[8];
#pragma unroll
                        for (int n = 0; n < 2; ++n)
#pragma unroll
                            for (int j = 0; j < 4; ++j) { const int e = 4 * n + j; const f32x4 E = bj ? ec[e >> 1] : er[e >> 1];
                                const float c = (e & 1) ? E[2] : E[0], sn = (e & 1) ? E[3] : E[1];
                                const float y = acc[ai][bj][m][n][j] * rstd * wv[bj][n][j]; float py; { auto r32 = __builtin_amdgcn_permlane32_swap(__float_as_uint(y), __float_as_uint(y), false, false); py = __uint_as_float(fq < 2 ? r32[1] : r32[0]); }
                                ov[e] = (isx1 ? (y * c - py * sn) : (y * c + py * sn)) * sc; }
                        u32x4 w; w.x = cvt_pk_bf16(ov[0], ov[1]); w.y = cvt_pk_bf16(ov[2], ov[3]); w.z = cvt_pk_bf16(ov[4], ov[5]); w.w = cvt_pk_bf16(ov[6], ov[7]);
                        *(u32x4*)(obase + row * opitch + 32 * bj + 8 * fq) = w; }
                }
            }
        }
    }
};
}

template <int REMAP>
__device__ __forceinline__ void transpose_item(const float* __restrict__ W, int N, bf16* __restrict__ WT, int k0, int n0, int lane) {
    const int n = n0 + 4 * lane;
    int drow = n;
    if (REMAP == 1) { const int isup = n >= 2048; const int s = isup ? n - 2048 : n; drow = 256 * (s >> 7) + (isup ? 128 : 0) + (s & 127); }
    if (REMAP == 2) { const int c = n & 255; drow = (n & ~255) + 128 * ((c & 63) >> 5) + 32 * (c >> 6) + (c & 31); }
#pragma unroll 2
    for (int kc = 0; kc < 8; ++kc) {
        const int k = k0 + 8 * kc;
        f32x4 v[8];
#pragma unroll
        for (int i = 0; i < 8; ++i) v[i] = __builtin_nontemporal_load((const f32x4*)(W + (size_t)(k + i) * N + n));
        __builtin_amdgcn_sched_barrier(0);
#pragma unroll
        for (int j = 0; j < 4; ++j) { v4u o; o.x = pk2(v[0][j], v[1][j]); o.y = pk2(v[2][j], v[3][j]); o.z = pk2(v[4][j], v[5][j]); o.w = pk2(v[6][j], v[7][j]);
            *(v4u*)(WT + (size_t)(drow + j) * 2048 + k) = o; }
    }
}
template <int REMAP>
__device__ __forceinline__ void transpose_item_f8(const float* __restrict__ W, int N, unsigned char* __restrict__ WT, int k0, int n0, int lane, float sc) {
    const int n = n0 + 4 * lane;
    int drow = n;
    if (REMAP == 1) { const int isup = n >= 2048; const int s = isup ? n - 2048 : n; drow = 256 * (s >> 7) + (isup ? 128 : 0) + (s & 127); }
#pragma unroll 1
    for (int kc = 0; kc < 4; ++kc) {
        const int k = k0 + 16 * kc;
        f32x4 v[16];
#pragma unroll
        for (int i = 0; i < 16; ++i) v[i] = __builtin_nontemporal_load((const f32x4*)(W + (size_t)(k + i) * N + n));
        __builtin_amdgcn_sched_barrier(0);
#pragma unroll
        for (int i = 0; i < 16; ++i) v[i] = v[i] * sc;
#pragma unroll
        for (int j = 0; j < 4; ++j) { v4u o; o.x = pg8::pk4_fp8(v[0][j], v[1][j], v[2][j], v[3][j]); o.y = pg8::pk4_fp8(v[4][j], v[5][j], v[6][j], v[7][j]);
            o.z = pg8::pk4_fp8(v[8][j], v[9][j], v[10][j], v[11][j]); o.w = pg8::pk4_fp8(v[12][j], v[13][j], v[14][j], v[15][j]);
            *(v4u*)(WT + (size_t)(drow + j) * 2048 + k) = o; }
    }
}
__device__ __forceinline__ void rms_row_to_bf16(const float* __restrict__ xrow, const f32x4 (&wv)[8], bf16* __restrict__ orow, unsigned char* __restrict__ orow8, int lane) {
    const f32x4* xr = (const f32x4*)xrow + lane;
    f32x4 v[8]; float ss = 0.f;
#pragma unroll
    for (int j = 0; j < 8; ++j) v[j] = xr[64 * j];
    __builtin_amdgcn_sched_barrier(0);
#pragma unroll
    for (int j = 0; j < 8; ++j) ss += (v[j].x * v[j].x + v[j].y * v[j].y) + (v[j].z * v[j].z + v[j].w * v[j].w);
    const float rstd = rsqrtf(wave_sum(ss) * (1.f / 2048.f) + NORM_EPS);
    v2u* o8 = (v2u*)orow + lane;
#pragma unroll
    for (int j = 0; j < 8; ++j) { const f32x4 ww = wv[j]; const float h0 = v[j].x * rstd * ww.x, h1 = v[j].y * rstd * ww.y, h2 = v[j].z * rstd * ww.z, h3 = v[j].w * rstd * ww.w;
        v2u o; o.x = pk2(h0, h1); o.y = pk2(h2, h3); o8[64 * j] = o; ((unsigned*)orow8)[lane + 64 * j] = pg8::pk4_fp8(h0, h1, h2, h3); }
}
__device__ __forceinline__ void moe_weight_convert_blk(const float* __restrict__ w_gate_up, const float* __restrict__ w_down, unsigned char* __restrict__ Wgu8, unsigned char* __restrict__ Wd8,
                                                       unsigned char* ldsb, int blk, int nblk, int wave, int lane, float sc) {
    constexpr int I_GU = 8 * 16, I_D = 8 * 8, NIT = NE * (I_GU + I_D);
    asm volatile("" : "+v"(lane));
    f32x4 v[32];
#define MWC_DECODE(it_, src_, N_, dst_, k0_, n0_, gu_) do { if ((it_) < NE * I_GU) { const int e_ = (it_) / I_GU, q_ = (it_) % I_GU; src_ = w_gate_up + (size_t)e_ * 2048 * 4096; N_ = 4096; dst_ = Wgu8 + (size_t)e_ * 4096 * 2048; k0_ = 256 * (q_ / 16); n0_ = 256 * (q_ % 16); gu_ = 1; } \
        else { const int r_ = (it_) - NE * I_GU, e_ = r_ / I_D, q_ = r_ % I_D; src_ = w_down + (size_t)e_ * 2048 * 2048; N_ = 2048; dst_ = Wd8 + (size_t)e_ * 2048 * 2048; k0_ = 256 * (q_ / 8); n0_ = 256 * (q_ % 8); gu_ = 0; } } while (0)
#define MWC_LOAD(src_, N_, k0_, n0_) do { const float* p_ = (src_) + (size_t)((k0_) + 32 * wave) * (N_) + (n0_) + 4 * lane; _Pragma("unroll") for (int r_ = 0; r_ < 32; ++r_) v[r_] = __builtin_nontemporal_load((const f32x4*)(p_ + (size_t)r_ * (N_))); } while (0)
    int it = blk, buf = 0;
    const float* src = w_gate_up; unsigned char* dst = Wgu8; int N = 4096, k0 = 0, n0 = 0, gu = 1;
    if (it < NIT) { MWC_DECODE(it, src, N, dst, k0, n0, gu); MWC_LOAD(src, N, k0, n0); }
    for (; it < NIT; it += nblk) {
        __builtin_amdgcn_sched_barrier(0);
        unsigned char* img = ldsb + buf * 65536;
#pragma unroll
        for (int j = 0; j < 4; ++j) {
#pragma unroll
            for (int hh = 0; hh < 2; ++hh) { v4u o; o.x = pg8::pk4_fp8(v[16 * hh + 0][j] * sc, v[16 * hh + 1][j] * sc, v[16 * hh + 2][j] * sc, v[16 * hh + 3][j] * sc); o.y = pg8::pk4_fp8(v[16 * hh + 4][j] * sc, v[16 * hh + 5][j] * sc, v[16 * hh + 6][j] * sc, v[16 * hh + 7][j] * sc);
                o.z = pg8::pk4_fp8(v[16 * hh + 8][j] * sc, v[16 * hh + 9][j] * sc, v[16 * hh + 10][j] * sc, v[16 * hh + 11][j] * sc); o.w = pg8::pk4_fp8(v[16 * hh + 12][j] * sc, v[16 * hh + 13][j] * sc, v[16 * hh + 14][j] * sc, v[16 * hh + 15][j] * sc);
                *(v4u*)(img + (4 * lane + j) * 256 + 16 * ((2 * wave + hh) ^ (lane & 7))) = o; } }
        asm volatile("s_waitcnt lgkmcnt(0)" ::: "memory"); __builtin_amdgcn_s_barrier();
        __builtin_amdgcn_sched_barrier(0);
        const int nxt = it + nblk; const unsigned char* cdst = dst; const int ck0 = k0, cn0 = n0, cgu = gu;
        if (nxt < NIT) { MWC_DECODE(nxt, src, N, dst, k0, n0, gu); MWC_LOAD(src, N, k0, n0); }
        __builtin_amdgcn_sched_barrier(0);
#pragma unroll
        for (int qq = 0; qq < 2; ++qq) {
            v4u dd[4];
#pragma unroll
            for (int q = 0; q < 4; ++q) { const int n = 32 * wave + 16 * qq + 4 * q + (lane >> 4), c = lane & 15; dd[q] = *(const v4u*)(img + n * 256 + 16 * (c ^ ((n >> 2) & 7))); }
            __builtin_amdgcn_sched_barrier(0);
#pragma unroll
            for (int q = 0; q < 4; ++q) { const int n = 32 * wave + 16 * qq + 4 * q + (lane >> 4), c = lane & 15;
                const int ng = cn0 + n; int drow = ng;
                if (cgu) { const int isup = cn0 >= 2048; const int s = isup ? ng - 2048 : ng; drow = 256 * (s >> 7) + (isup ? 128 : 0) + (s & 127); }
                *(v4u*)((unsigned char*)cdst + (size_t)drow * 2048 + ck0 + 16 * c) = dd[q]; }
        }
        buf ^= 1;
    }
    asm volatile("s_waitcnt vmcnt(0) lgkmcnt(0)" ::: "memory"); __builtin_amdgcn_s_barrier();
#undef MWC_DECODE
#undef MWC_LOAD
}
__device__ __forceinline__ v4u bf8_to_h8(v4u r) {
    typedef _Float16 h2v __attribute__((ext_vector_type(2)));
    v4u o;
    { f32x2 t = {bflo(r.x), bfhi(r.x)}; o.x = __builtin_bit_cast(unsigned, __builtin_convertvector(t, h2v)); }
    { f32x2 t = {bflo(r.y), bfhi(r.y)}; o.y = __builtin_bit_cast(unsigned, __builtin_convertvector(t, h2v)); }
    { f32x2 t = {bflo(r.z), bfhi(r.z)}; o.z = __builtin_bit_cast(unsigned, __builtin_convertvector(t, h2v)); }
    { f32x2 t = {bflo(r.w), bfhi(r.w)}; o.w = __builtin_bit_cast(unsigned, __builtin_convertvector(t, h2v)); }
    return o;
}
__device__ __forceinline__ unsigned umax4(unsigned m, v4u r) {
    const unsigned w[4] = {r.x, r.y, r.z, r.w};
#pragma unroll
    for (int i = 0; i < 4; ++i) { const unsigned lo = w[i] & 0x7fffu, hi = (w[i] >> 16) & 0x7fffu; m = m > lo ? m : lo; m = m > hi ? m : hi; }
    return m;
}
__device__ __forceinline__ void moe_tables(unsigned* gcnt, int* tile_e, int* ppad, int* ecnt, int tid) {
    __syncthreads();
    if (tid == 0) { int acc = 0;
        for (int e = 0; e < NE; ++e) { const int c = (int)__hip_atomic_load(gcnt + e, RLX_AGENT); const int nt = (c + 255) >> 8; ppad[e] = acc * 256; ecnt[e] = c; for (int t = 0; t < nt; ++t) tile_e[acc + t] = e; acc += nt; }
        ppad[32] = acc * 256; ppad[33] = acc; }
    __syncthreads();
}

struct Args { const float* in[15]; float* out; unsigned char* ws; int ph_lo, ph_hi; };
__global__ void __launch_bounds__(NWAVES * 64, 2) mk_fwd(Args args) {
    extern __shared__ __attribute__((aligned(16))) unsigned char lds[];
    const int tid = threadIdx.x, lane = tid & 63, wave = __builtin_amdgcn_readfirstlane(tid >> 6);
    const int G = gridDim.x, bx = blockIdx.x;
    const int nx = (G % 8 == 0) ? 8 : 1, gx = G / nx;
    const int vcu = (bx % nx) * gx + bx / nx;
    const int gw = vcu * NWAVES + wave, NGW = G * NWAVES;
    unsigned char* ws = args.ws;
    unsigned* ctl = (unsigned*)(ws + WS_CTL);
    const float* x = args.in[0]; const float* norm_mix_w = args.in[1]; const float* w_in = args.in[2]; const float* q_norm_w = args.in[3]; const float* k_norm_w = args.in[4];
    const float* out_norm_w = args.in[5]; const float* w_out = args.in[6]; const float* norm_moe_w = args.in[7]; const float* w_router = args.in[8]; const float* b_router = args.in[9];
    const float* w_gate_up = args.in[10]; const float* b_gate_up = args.in[11]; const float* w_down = args.in[12]; const float* b_down = args.in[13]; const float* final_norm_w = args.in[14];
    float* out = args.out;
    f32x2* rope = (f32x2*)(ws + WS_ROPE);
    bf16* WrT = (bf16*)(ws + WS_WRT); bf16* WinT = (bf16*)(ws + WS_WIN); bf16* WoutT = (bf16*)(ws + WS_WOUT); unsigned char* Wgu8 = ws + WS_WGU; unsigned char* Wd8 = ws + WS_WD;
    bf16* Hn = (bf16*)(ws + WS_HN); bf16* P = (bf16*)(ws + WS_P); bf16* PB = (bf16*)(ws + WS_P + 144 * MiB); bf16* Qn = (bf16*)(ws + WS_QN); bf16* Kn = (bf16*)(ws + WS_KN); bf16* Vn = (bf16*)(ws + WS_VN); bf16* Oa = (bf16*)(ws + WS_OA);
    bf16* Ob = (bf16*)(ws + WS_OB); float* Lse = (float*)(ws + WS_LSE); bf16* Mg = (bf16*)(ws + WS_MG); bf16* X1 = (bf16*)(ws + WS_X1);
    int* Eidx = (int*)(ws + WS_EIDX); int* Rank = (int*)(ws + WS_RANK); float* Gate = (float*)(ws + WS_GATE);
    unsigned char* Y8 = ws + WS_XG; unsigned char* Hact8 = ws + WS_H + 272 * MiB; unsigned char* Hnx8 = ws + WS_H;
    unsigned char* Win8 = ws + WS_WIN + 9 * MiB;                    unsigned char* Hn8 = ws + WS_HN;
    constexpr float WSC = 32.0f, WSC_INV = 1.0f / 32.0f;
    unsigned* gcnt = ctl + CW_CNT;
    int* tile_e = (int*)(lds + TBL_OFF); int* ppad = (int*)(lds + PP_OFF); int* ecnt = (int*)(lds + CNT_OFF); int* tokbuf = (int*)(lds + ROUTE_OFF);
    int* TokOf = (int*)(ws + WS_TOKOF);

    for (int u = tid; u < (LDS_BYTES - LDSCTL_OFF) / 4; u += NWAVES * 64) ((unsigned*)(lds + LDSCTL_OFF))[u] = 0u;
    __syncthreads();
#if MK_SPLIT
#define GRID_BAR() do { } while (0)
#define GRID_BAR_F() (void)0
#else
    XcdBarrier bar = xcd_barrier_post(ctl + CW_BAR, (volatile LAS unsigned*)(lds + MISC_OFF) + 8);
#define GRID_BAR() xcd_barrier(bar)
#define GRID_BAR_F() xcd_barrier(bar)
#endif
    const int lo = args.ph_lo, hi_ph = args.ph_hi;
#define IN(k) (lo <= (k) && (k) < hi_ph)
#ifndef PROBE_MASK
#define PROBE_MASK 0
#endif
#define PHASE_REP(k) _Pragma("unroll") for (int rep_ = 0; rep_ <= ((PROBE_MASK >> (k)) & 1); ++rep_) if (rep_ > 0 && (GRID_BAR_F(), false)) {} else
#define PHASE_LANE() int lane_l_ = (int)__builtin_amdgcn_mbcnt_hi(~0u, __builtin_amdgcn_mbcnt_lo(~0u, 0u)); asm volatile("" : "+v"(lane_l_)); const int lane = lane_l_, tid = wave * 64 + lane_l_; (void)tid
#define BOTH(k) (IN(k) && IN((k) + 1))

    if (IN(0)) { PHASE_REP(0) {
        PHASE_LANE();
        constexpr int I_IN = 32 * 27, I_OUT = 32 * 8;
        constexpr int NITEMS = I_IN + I_OUT;
        for (int it = gw; it < NITEMS; it += NGW) {
            int r = it;
            if (r < I_IN) { const int nb = r % 27; if (nb < 9) transpose_item<2>(w_in, INW, WinT, 64 * (r / 27), 256 * nb, lane); else transpose_item_f8<0>(w_in, INW, Win8 - (size_t)2304 * 2048, 64 * (r / 27), 256 * nb, lane, WSC); continue; } r -= I_IN;
            transpose_item<0>(w_out, DM, WoutT, 64 * (r / 8), 256 * (r % 8), lane);
        }
        const int gt = gw * 64 + lane;
        if (gt < 8192) { const int n = gt & 31, kc = gt >> 5; float v[8];
#pragma unroll
            for (int i = 0; i < 8; ++i) v[i] = w_router[(size_t)(8 * kc + i) * NE + n];
            v4u o; o.x = pk2(v[0], v[1]); o.y = pk2(v[2], v[3]); o.z = pk2(v[4], v[5]); o.w = pk2(v[6], v[7]);
            *(v4u*)(WrT + (size_t)n * 2048 + 8 * kc) = o; }
        if (gt >= 8192 && gt < 8192 + 4096) { const int id = gt - 8192, pos = id >> 4, i = id & 15;
            double th = 1.0; for (int q = 0; q < i; ++q) th *= 0.56234132519034908;
            double c = 1.0, s = th, tc = 1.0, tsn = th; const double t2 = th * th;
            for (int n = 1; n <= 11; ++n) { tc *= -t2 / (double)((2 * n - 1) * (2 * n)); c += tc; tsn *= -t2 / (double)((2 * n) * (2 * n + 1)); s += tsn; }
            double rc = 1.0, rs = 0.0, bc = c, bs = s;
            for (int bit = 0; bit < 9; ++bit) { if ((pos >> bit) & 1) { const double t = rc * bc - rs * bs; rs = rc * bs + rs * bc; rc = t; } const double t = bc * bc - bs * bs; bs = 2.0 * bc * bs; bc = t; }
            f32x2 cs; cs.x = (float)rc; cs.y = (float)rs; rope[id] = cs; }
        { f32x4 wv[8];
#pragma unroll
          for (int j = 0; j < 8; ++j) wv[j] = ((const f32x4*)norm_mix_w)[lane + 64 * j];
          for (int m = gw; m < MTOK; m += NGW) rms_row_to_bf16(x + (size_t)m * DM, wv, Hn + (size_t)m * DM, Hnx8 + (size_t)m * DM, lane); }
        }
        if (BOTH(0)) GRID_BAR();
    }

    if (IN(1)) { PHASE_REP(1) {
        PHASE_LANE();
        {
            float* ropeC = (float*)(lds + ROUTE_OFF);
            for (int i = tid; i < 2048; i += NWAVES * 64) ropeC[i] = ((const float*)rope)[i];
            __syncthreads();
            pg8::StaticOrder S; S.init(MTOK / 256, 9, G, bx);
            pg8::EpiInProjA E{ws, q_norm_w, k_norm_w, (const PG8_LAS float*)ropeC};
            pg8::gemm_phase<pg8::EpiInProjA, pg8::StaticOrder, true, true>((PG8_LAS unsigned char*)lds + RING_OFF, DM, (const char*)Hn, (const char*)WinT, S, E);
        }
        {
            pg8::BalancedOrder S; S.init(MTOK / 256, 18, G, bx, ((MTOK / 256) * 9) % G, 2, 1);
            pg8::EpiInProj E{P, PB, 9, WSC_INV};
            pg8::gemm_phase<pg8::EpiInProj, pg8::BalancedOrder, true, true, true>((PG8_LAS unsigned char*)lds + RING_OFF, DM / 2, (const char*)Hnx8, (const char*)Win8, S, E);
        }
        }
        if (BOTH(1)) GRID_BAR();
    }


    if (IN(3)) { PHASE_REP(3) {
        PHASE_LANE();
        bool conv_done = false;
        {
            const int per = 3072 / nx, xcd = vcu / gx, vi = vcu % gx;
            float mq = 0.f, mk = 0.f;
            for (int i = 0; i < 64; ++i) { mq = fmaxf(mq, fabsf(q_norm_w[i])); mk = fmaxf(mk, fabsf(k_norm_w[i])); }
            const float b2 = 8.0f * 1.4426950408889634f * mq * mk;
            const float vmaxf = __uint_as_float(__hip_atomic_load(ctl + CW_VMAX, RLX_AGENT) << 16);
            const bool fixed_ref = b2 <= 14.0f && vmaxf < 6.0e4f;
            const float mref = fmaxf(b2 - 9.0f, 0.0f);
            const int rounds = (per + gx - 1) / gx, cslot = vcu % rounds; int ri = 0;
            for (int li = vi; li < per; li += gx, ++ri) {
                if (ri == cslot) { moe_weight_convert_blk(w_gate_up, w_down, Wgu8, Wd8, lds + RING_OFF, vcu, G, wave, lane, WSC); conv_done = true; }
                const int u = xcd * per + li;
                const int qb = u & 63, g4 = (u >> 6) & 3, kvh = (u >> 8) % 6, b = u / 1536, qh = kvh * 4 + g4;
                const size_t qoff = ((size_t)b * SEQ + (size_t)qb * 256) * AQW + qh * 64;
                const attn_body::bf16* kp = (const attn_body::bf16*)Kn + (size_t)b * SEQ * AKVW + kvh * 64; const attn_body::bf16* vp = (const attn_body::bf16*)Vn + (size_t)b * SEQ * AKVW + kvh * 64; const attn_body::bf16* vraw = (const attn_body::bf16*)P + (size_t)b * SEQ * 2304 + (AQW + AKVW) + kvh * 64;
                if (fixed_ref) attn_body::attn_unit<true, 8, AQW, AKVW, AKVW, AQW, SEQ / 64>((const attn_body::bf16*)Qn + qoff, kp, vp, (attn_body::bf16*)Oa + qoff, (char*)lds + RING_OFF, mref);
                else attn_body::attn_unit<false, 8, AQW, AKVW, 2304, AQW, SEQ / 64>((const attn_body::bf16*)Qn + qoff, kp, vraw, (attn_body::bf16*)Oa + qoff, (char*)lds + RING_OFF, 0.f);
            }
        }
        if (!conv_done) moe_weight_convert_blk(w_gate_up, w_down, Wgu8, Wd8, lds + RING_OFF, vcu, G, wave, lane, WSC);
        {
            attn_body::attnb_phase(vcu, G, (const attn_body::bf16*)PB, (attn_body::bf16*)Ob, Lse, (char*)lds + RING_OFF, ctl + CW_QB);
        }
        }
        if (BOTH(3)) GRID_BAR();
    }

    if (IN(4)) { PHASE_REP(4) {
        PHASE_LANE();
        f32x4 onw[8];
#pragma unroll
        for (int j = 0; j < 3; ++j) { onw[2 * j] = *(const f32x4*)(out_norm_w + 8 * (lane + 64 * j)); onw[2 * j + 1] = *(const f32x4*)(out_norm_w + 8 * (lane + 64 * j) + 4); }
        onw[6] = *(const f32x4*)(out_norm_w + AQW + 8 * lane); onw[7] = *(const f32x4*)(out_norm_w + AQW + 8 * lane + 4);
        for (int row = gw; row < MTOK; row += NGW) {
            float oa[24]; float ssa = 0.f;
#pragma unroll
            for (int j = 0; j < 3; ++j) { const v4u raw = *(const v4u*)(Oa + (size_t)row * AQW + 8 * (lane + 64 * j));
                oa[8 * j + 0] = bflo(raw.x); oa[8 * j + 1] = bfhi(raw.x); oa[8 * j + 2] = bflo(raw.y); oa[8 * j + 3] = bfhi(raw.y); oa[8 * j + 4] = bflo(raw.z); oa[8 * j + 5] = bfhi(raw.z); oa[8 * j + 6] = bflo(raw.w); oa[8 * j + 7] = bfhi(raw.w); }
#pragma unroll
            for (int i = 0; i < 24; ++i) ssa += oa[i] * oa[i];
            const float rsa = rsqrtf(wave_sum(ssa) * (1.f / 1536.f) + NORM_EPS);
            const int h = lane >> 3;
            const float l0 = Lse[((size_t)0 * MTOK + row) * 8 + h], l1 = Lse[((size_t)1 * MTOK + row) * 8 + h], l2 = Lse[((size_t)2 * MTOK + row) * 8 + h];
            const float lm = fmaxf(l0, fmaxf(l1, l2));
            float w0 = __builtin_amdgcn_exp2f(l0 - lm), w1 = __builtin_amdgcn_exp2f(l1 - lm), w2 = __builtin_amdgcn_exp2f(l2 - lm);
            const float wi = 1.0f / (w0 + w1 + w2); w0 *= wi; w1 *= wi; w2 *= wi;
            const v4u r0 = *(const v4u*)(Ob + ((size_t)0 * MTOK + row) * BW + 8 * lane), r1 = *(const v4u*)(Ob + ((size_t)1 * MTOK + row) * BW + 8 * lane), r2 = *(const v4u*)(Ob + ((size_t)2 * MTOK + row) * BW + 8 * lane);
            float ob[8];
            ob[0] = w0 * bflo(r0.x) + w1 * bflo(r1.x) + w2 * bflo(r2.x); ob[1] = w0 * bfhi(r0.x) + w1 * bfhi(r1.x) + w2 * bfhi(r2.x);
            ob[2] = w0 * bflo(r0.y) + w1 * bflo(r1.y) + w2 * bflo(r2.y); ob[3] = w0 * bfhi(r0.y) + w1 * bfhi(r1.y) + w2 * bfhi(r2.y);
            ob[4] = w0 * bflo(r0.z) + w1 * bflo(r1.z) + w2 * bflo(r2.z); ob[5] = w0 * bfhi(r0.z) + w1 * bfhi(r1.z) + w2 * bfhi(r2.z);
            ob[6] = w0 * bflo(r0.w) + w1 * bflo(r1.w) + w2 * bflo(r2.w); ob[7] = w0 * bfhi(r0.w) + w1 * bfhi(r1.w) + w2 * bfhi(r2.w);
            float ssb = 0.f;
#pragma unroll
            for (int i = 0; i < 8; ++i) ssb += ob[i] * ob[i];
            const float rsb = rsqrtf(wave_sum(ssb) * (1.f / 512.f) + NORM_EPS);
            bf16* mrow = Mg + (size_t)row * DM;
#pragma unroll
            for (int j = 0; j < 3; ++j) { const int c = 8 * (lane + 64 * j); const f32x4 wa = onw[2 * j], wb = onw[2 * j + 1];
                v4u o; o.x = pk2(oa[8 * j + 0] * rsa * wa.x, oa[8 * j + 1] * rsa * wa.y); o.y = pk2(oa[8 * j + 2] * rsa * wa.z, oa[8 * j + 3] * rsa * wa.w);
                o.z = pk2(oa[8 * j + 4] * rsa * wb.x, oa[8 * j + 5] * rsa * wb.y); o.w = pk2(oa[8 * j + 6] * rsa * wb.z, oa[8 * j + 7] * rsa * wb.w); *(v4u*)(mrow + c) = o; }
            { const int c = AQW + 8 * lane; const f32x4 wa = onw[6], wb = onw[7];
                v4u o; o.x = pk2(ob[0] * rsb * wa.x, ob[1] * rsb * wa.y); o.y = pk2(ob[2] * rsb * wa.z, ob[3] * rsb * wa.w); o.z = pk2(ob[4] * rsb * wb.x, ob[5] * rsb * wb.y); o.w = pk2(ob[6] * rsb * wb.z, ob[7] * rsb * wb.w); *(v4u*)(mrow + c) = o; }
        }
        }
        if (BOTH(4)) GRID_BAR();
    }

    if (IN(5)) { PHASE_REP(5) {
        PHASE_LANE();
        pg8::StaticOrder S; S.init(MTOK / 256, DM / 256, G, bx);
        pg8::EpiResidBf16 E{x, X1, DM};
        pg8::gemm_phase<pg8::EpiResidBf16, pg8::StaticOrder, true, true>((PG8_LAS unsigned char*)lds + RING_OFF, DM, (const char*)Mg, (const char*)WoutT, S, E);
        }
        if (BOTH(5)) GRID_BAR();
    }

    if (IN(6)) { PHASE_REP(6) {
        PHASE_LANE();
        int* lcnt = (int*)(lds + CNT_OFF); int* lbase = lcnt + 32; int* le = (int*)(lds + ROUTE_OFF); int* lrank = le + 512;
        float* logit = (float*)(lds + LOGIT_OFF); unsigned char* tile = lds + RING_OFF; float* part = (float*)(lds + RING_OFF);
        const int r32 = lane & 31, hi = lane >> 5;
        f32x4 wmo[8];
#pragma unroll
        for (int j = 0; j < 4; ++j) { wmo[2 * j] = *(const f32x4*)(norm_moe_w + 8 * (lane + 64 * j)); wmo[2 * j + 1] = *(const f32x4*)(norm_moe_w + 8 * (lane + 64 * j) + 4); }
        for (int chunk = bx; chunk < MTOK / 128; chunk += G) {
            if (tid < 32) lcnt[tid] = 0;
            __syncthreads();
#pragma unroll 1
            for (int grp = 0; grp < 4; ++grp) {
                const int row0 = chunk * 128 + grp * 32;
                v4u xr_[4][4];
#pragma unroll
                for (int rr = 0; rr < 4; ++rr)
#pragma unroll
                    for (int j = 0; j < 4; ++j) xr_[rr][j] = ((const v4u*)(X1 + ((size_t)row0 + 4 * wave + rr) * DM))[lane + 64 * j];
                __builtin_amdgcn_sched_barrier(0);
#pragma unroll
                for (int rr = 0; rr < 4; ++rr) {
                    const int r = 4 * wave + rr; const size_t grow = (size_t)row0 + r;
                    float xv[4][8]; float ss = 0.f;
#pragma unroll
                    for (int j = 0; j < 4; ++j) { const v4u q = xr_[rr][j]; xv[j][0] = bflo(q.x); xv[j][1] = bfhi(q.x); xv[j][2] = bflo(q.y); xv[j][3] = bfhi(q.y); xv[j][4] = bflo(q.z); xv[j][5] = bfhi(q.z); xv[j][6] = bflo(q.w); xv[j][7] = bfhi(q.w);
#pragma unroll
                        for (int i = 0; i < 8; ++i) ss += xv[j][i] * xv[j][i]; }
                    const float rstd = rsqrtf(wave_sum(ss) * (1.f / 2048.f) + NORM_EPS);
#pragma unroll
                    for (int j = 0; j < 4; ++j) { const f32x4 wa = wmo[2 * j], wb = wmo[2 * j + 1];
                        const float h0 = xv[j][0] * rstd * wa.x, h1 = xv[j][1] * rstd * wa.y, h2 = xv[j][2] * rstd * wa.z, h3 = xv[j][3] * rstd * wa.w;
                        const float h4 = xv[j][4] * rstd * wb.x, h5 = xv[j][5] * rstd * wb.y, h6 = xv[j][6] * rstd * wb.z, h7 = xv[j][7] * rstd * wb.w;
                        v4u o; o.x = pk2(h0, h1); o.y = pk2(h2, h3); o.z = pk2(h4, h5); o.w = pk2(h6, h7);
                        v2u o8; o8.x = pg8::pk4_fp8(h0, h1, h2, h3); o8.y = pg8::pk4_fp8(h4, h5, h6, h7);
                        ((v2u*)(Hn8 + grow * DM))[lane + 64 * j] = o8;
                        *(v4u*)(tile + (lane + 64 * j) * 512 + r * 16) = o; }
                }
                __syncthreads();
                f32x16 acc = f32x16{};
#pragma unroll 4
                for (int s = 0; s < 16; ++s) { const int kk = 16 * wave + s;
                    const bf16x8 a = *(const bf16x8*)(tile + ((kk * 2 + hi) * 32 + r32) * 16);
                    const bf16x8 b = *(const bf16x8*)(WrT + (size_t)r32 * 2048 + 16 * kk + 8 * hi);
                    acc = __builtin_amdgcn_mfma_f32_32x32x16_bf16(a, b, acc, 0, 0, 0); }
                __syncthreads();
#pragma unroll
                for (int r = 0; r < 16; ++r) part[(wave * 32 + ((r & 3) + 8 * (r >> 2) + 4 * hi)) * 33 + r32] = acc[r];
                __syncthreads();
#pragma unroll
                for (int q = 0; q < 2; ++q) { const int idx = tid * 2 + q, row = idx >> 5, e = idx & 31; float sm = 0.f;
#pragma unroll
                    for (int w = 0; w < 8; ++w) sm += part[(w * 32 + row) * 33 + e];
                    logit[row * 33 + e] = sm + b_router[e]; }
                __syncthreads();
                if (tid < 32) { const int row = tid; unsigned taken = 0u; float tv[4]; int te[4];
#pragma unroll
                    for (int k = 0; k < 4; ++k) { float best = -INFINITY; int bi = 0;
                        for (int e = 0; e < 32; ++e) { const float v = logit[row * 33 + e]; const bool ok = !((taken >> e) & 1u) && (v > best); best = ok ? v : best; bi = ok ? e : bi; }
                        taken |= 1u << bi; tv[k] = best; te[k] = bi; }
                    float ex[4], sum = 0.f;
#pragma unroll
                    for (int k = 0; k < 4; ++k) { ex[k] = __builtin_amdgcn_exp2f((tv[k] - tv[0]) * 1.4426950408889634f); sum += ex[k]; }
                    const float inv = 1.0f / sum; const size_t grow = (size_t)row0 + row;
                    f32x4 gv = {ex[0] * inv, ex[1] * inv, ex[2] * inv, ex[3] * inv}; *(f32x4*)(Gate + grow * 4) = gv;
#pragma unroll
                    for (int k = 0; k < 4; ++k) { const int lr = __hip_atomic_fetch_add(lcnt + te[k], 1, __ATOMIC_RELAXED, __HIP_MEMORY_SCOPE_WORKGROUP); le[(grp * 32 + row) * 4 + k] = te[k]; lrank[(grp * 32 + row) * 4 + k] = lr; }
                }
                __syncthreads();
            }
            if (tid < 32) lbase[tid] = (int)__hip_atomic_fetch_add(gcnt + tid, (unsigned)lcnt[tid], RLX_AGENT);
            __syncthreads();
            { const size_t gi = (size_t)chunk * 512 + tid; const int e = le[tid]; const int rk = lbase[e] + lrank[tid]; Eidx[gi] = e; Rank[gi] = rk; TokOf[(size_t)e * 32768 + rk] = (int)(gi >> 2); }
            __syncthreads();
        }
        }
        if (BOTH(6)) GRID_BAR();
    }


    if (IN(8)) { PHASE_REP(8) {
        PHASE_LANE();
        moe_tables(gcnt, tile_e, ppad, ecnt, tid);
        pg8::MoeGatherOrder S; S.so.init(__builtin_amdgcn_readfirstlane(ppad[33]), 16, G, bx); S.tile_e = (const PG8_LAS int*)tile_e; S.ppad = (const PG8_LAS int*)ppad; S.ecnt = (const PG8_LAS int*)ecnt;
        S.tokof = TokOf; S.tokbuf = (PG8_LAS int*)tokbuf; S.dt.init(ctl + CW_Q8, (PG8_LAS int*)(lds + QW_OFF), S.so.nwg, G);
        pg8::EpiSwiglu E{Hact8, b_gate_up, WSC_INV, (PG8_LAS float*)(lds + LOGIT_OFF)};
        pg8::gemm_phase<pg8::EpiSwiglu, pg8::MoeGatherOrder, true, true, true, true>((PG8_LAS unsigned char*)lds + RING_OFF, DM / 2, (const char*)Hn8, (const char*)Wgu8, S, E);
        }
        if (BOTH(8)) GRID_BAR();
    }

    if (IN(9)) { PHASE_REP(9) {
        PHASE_LANE();
        moe_tables(gcnt, tile_e, ppad, ecnt, tid);
        pg8::MoeOrder S; S.so.init(__builtin_amdgcn_readfirstlane(ppad[33]), 8, G, bx); S.tile_e = (const PG8_LAS int*)tile_e; S.dt.init(ctl + CW_Q9, (PG8_LAS int*)(lds + QW_OFF), S.so.nwg, G);
        pg8::EpiFp8 E{Y8, DM, b_down, DM, WSC_INV, (PG8_LAS float*)(lds + LOGIT_OFF)};
        pg8::gemm_phase<pg8::EpiFp8, pg8::MoeOrder, true, true, true>((PG8_LAS unsigned char*)lds + RING_OFF, DM / 2, (const char*)Hact8, (const char*)Wd8, S, E);
        }
        if (BOTH(9)) GRID_BAR();
    }

    if (IN(10)) { PHASE_REP(10) {
        PHASE_LANE();
        moe_tables(gcnt, tile_e, ppad, ecnt, tid);
        f32x4 fw[8];
#pragma unroll
        for (int j = 0; j < 4; ++j) { fw[2 * j] = *(const f32x4*)(final_norm_w + 8 * (lane + 64 * j)); fw[2 * j + 1] = *(const f32x4*)(final_norm_w + 8 * (lane + 64 * j) + 4); }
        for (int row = gw; row < MTOK; row += NGW) {
            const f32x4 gv = *(const f32x4*)(Gate + (size_t)row * 4);
            const int p0 = ppad[Eidx[(size_t)row * 4 + 0]] + Rank[(size_t)row * 4 + 0], p1 = ppad[Eidx[(size_t)row * 4 + 1]] + Rank[(size_t)row * 4 + 1];
            const int p2 = ppad[Eidx[(size_t)row * 4 + 2]] + Rank[(size_t)row * 4 + 2], p3 = ppad[Eidx[(size_t)row * 4 + 3]] + Rank[(size_t)row * 4 + 3];
            v4u xq[4]; v2u yq[4][4];
#pragma unroll
            for (int j = 0; j < 4; ++j) xq[j] = ((const v4u*)(X1 + (size_t)row * DM))[lane + 64 * j];
#pragma unroll
            for (int j = 0; j < 4; ++j) { yq[0][j] = ((const v2u*)(Y8 + (size_t)p0 * DM))[lane + 64 * j]; yq[1][j] = ((const v2u*)(Y8 + (size_t)p1 * DM))[lane + 64 * j];
                yq[2][j] = ((const v2u*)(Y8 + (size_t)p2 * DM))[lane + 64 * j]; yq[3][j] = ((const v2u*)(Y8 + (size_t)p3 * DM))[lane + 64 * j]; }
            __builtin_amdgcn_sched_barrier(0);
            float v[4][8]; float ss = 0.f;
#pragma unroll
            for (int j = 0; j < 4; ++j) { const v4u q = xq[j]; v[j][0] = bflo(q.x); v[j][1] = bfhi(q.x); v[j][2] = bflo(q.y); v[j][3] = bfhi(q.y); v[j][4] = bflo(q.z); v[j][5] = bfhi(q.z); v[j][6] = bflo(q.w); v[j][7] = bfhi(q.w);
#pragma unroll
                for (int k = 0; k < 4; ++k) { const float g = gv[k]; const v2u y = yq[k][j];
                    const f32x2 a = __builtin_amdgcn_cvt_pk_f32_fp8((int)y.x, false), b = __builtin_amdgcn_cvt_pk_f32_fp8((int)y.x, true), c = __builtin_amdgcn_cvt_pk_f32_fp8((int)y.y, false), d = __builtin_amdgcn_cvt_pk_f32_fp8((int)y.y, true);
                    v[j][0] += g * a.x; v[j][1] += g * a.y; v[j][2] += g * b.x; v[j][3] += g * b.y; v[j][4] += g * c.x; v[j][5] += g * c.y; v[j][6] += g * d.x; v[j][7] += g * d.y; }
#pragma unroll
                for (int i = 0; i < 8; ++i) ss += v[j][i] * v[j][i]; }
            const float rstd = rsqrtf(wave_sum(ss) * (1.f / 2048.f) + NORM_EPS);
            float* orow = out + (size_t)row * DM;
#pragma unroll
            for (int j = 0; j < 4; ++j) { const f32x4 wa = fw[2 * j], wb = fw[2 * j + 1]; const int c = 8 * (lane + 64 * j);
                f32x4 o0 = {v[j][0] * rstd * wa.x, v[j][1] * rstd * wa.y, v[j][2] * rstd * wa.z, v[j][3] * rstd * wa.w}, o1 = {v[j][4] * rstd * wb.x, v[j][5] * rstd * wb.y, v[j][6] * rstd * wb.z, v[j][7] * rstd * wb.w};
                *(f32x4*)(orow + c) = o0; *(f32x4*)(orow + c + 4) = o1; }
        }
        }
    }
#undef IN
#undef BOTH
}

extern "C" void kernel_launch(void* const* d_in, const int* in_sizes, int n_in, void* d_out, int out_size, void* d_ws, size_t ws_size, hipStream_t stream) {
    static int grid = 0;
    if (grid == 0) {
        if (n_in != 15 || in_sizes[0] != MTOK * DM || out_size != MTOK * DM || ws_size < WS_END) { fprintf(stderr, "kernel_launch: unexpected shapes / workspace (n_in %d, ws %zu < %zu); nothing launched\n", n_in, ws_size, (size_t)WS_END); grid = -1; return; }
        int dev = 0, cus = 0, per_cu = 0;
        if (hipGetDevice(&dev) != hipSuccess || hipDeviceGetAttribute(&cus, hipDeviceAttributeMultiprocessorCount, dev) != hipSuccess) { grid = -1; return; }
        if (hipFuncSetAttribute((const void*)mk_fwd, hipFuncAttributeMaxDynamicSharedMemorySize, LDS_BYTES) != hipSuccess) { fprintf(stderr, "kernel_launch: hipFuncSetAttribute failed\n"); grid = -1; return; }
        if (hipOccupancyMaxActiveBlocksPerMultiprocessor(&per_cu, (const void*)mk_fwd, NWAVES * 64, LDS_BYTES) != hipSuccess || per_cu < 1) fprintf(stderr, "kernel_launch: occupancy query reports %d blocks per CU\n", per_cu);
        (void)hipGetLastError();
        grid = cus;
    }
    if (grid < 0) return;
    if (hipMemsetAsync((char*)d_ws + WS_CTL, 0, CTL_ZERO_BYTES, stream) != hipSuccess) return;
    Args a{};
    for (int i = 0; i < 15; ++i) a.in[i] = (const float*)d_in[i];
    a.out = (float*)d_out; a.ws = (unsigned char*)d_ws;
#if MK_SPLIT
    for (int k = 0; k < N_PHASES; ++k) { a.ph_lo = k; a.ph_hi = k + 1; hipLaunchKernelGGL(mk_fwd, dim3(grid), dim3(NWAVES * 64), LDS_BYTES, stream, a); }
#else
    a.ph_lo = 0; a.ph_hi = N_PHASES;
    hipLaunchKernelGGL(mk_fwd, dim3(grid), dim3(NWAVES * 64), LDS_BYTES, stream, a);
#endif
    const hipError_t le = hipPeekAtLastError();
    if (le != hipSuccess) fprintf(stderr, "kernel_launch: launch failed: %s\n", hipGetErrorName(le));
}
```

```cpp
#include <hip/hip_runtime.h>
#include <hip/hip_bf16.h>
#include <cstdio>
#include <cstdint>
#include <cmath>

#ifndef MK_SPLIT
#define MK_SPLIT 0
#endif

namespace pg8 {
#define PG8_LAS __attribute__((address_space(3)))
typedef unsigned short bf16_t;
typedef short bf16x8 __attribute__((ext_vector_type(8)));
typedef float f32x4 __attribute__((ext_vector_type(4)));
typedef unsigned u32x4 __attribute__((ext_vector_type(4)));
typedef unsigned u32x2 __attribute__((ext_vector_type(2)));
constexpr int BM = 256, BK = 64, HALF = 128, HTB = HALF * BK * 2  , STAGE_BYTES = 8 * HTB, NXCD = 8, WGM = 8;

__host__ __device__ __forceinline__ int lds_byte(int r, int c) { const int st = (r >> 4) * 2 + (c >> 5), rr = r & 15, cc = c & 31, ob = rr * 64 + cc * 2; return st * 1024 + (ob ^ (((ob >> 9) & 1) << 5)); }
__host__ __device__ __forceinline__ void stage_rc(int b, int& R, int& C) { const int st = b / 1024, sb = b % 1024, swz = sb ^ (((sb >> 9) & 1) << 5); R = (st >> 1) * 16 + swz / 64; C = (st & 1) * 32 + (swz % 64) / 2; }
__host__ __device__ __forceinline__ int perm32(int rho) { const int n = rho >> 4, i = rho & 15; return 8 * (i >> 2) + 4 * n + (i & 3); }

struct Unit { int pm, pn, e, r0, cnt; };

struct StaticOrder {
    int nM, nN, nwg, G, c;
    __device__ __forceinline__ void init(int nM_, int nN_, int G_, int c_) { nM = nM_; nN = nN_; nwg = nM * nN; G = G_; c = c_; }
    __device__ __forceinline__ bool next(int i, Unit& u) const { return at((long)i * G + c, u); }
    __device__ __forceinline__ bool at(const long L, Unit& u) const {
        if (L >= nwg) return false;
        int wgid = (int)L; { const int q = nwg / NXCD, r = nwg % NXCD, xcd = wgid % NXCD, off = wgid / NXCD; wgid = (xcd < r ? xcd * (q + 1) : r * (q + 1) + (xcd - r) * q) + off; }
        const int nig = WGM * nN, gid = wgid / nig, fm = gid * WGM, gsz = (nM - fm) < WGM ? (nM - fm) : WGM;
        u.pm = fm + ((wgid % nig) % gsz); u.pn = (wgid % nig) / gsz; u.e = 0; u.r0 = 0; u.cnt = 0; return true;
    }
    __device__ __forceinline__ int apos(const Unit& u) const { return u.pm; }
    __device__ __forceinline__ int bpos(const Unit& u) const { return u.pn; }
    __device__ __forceinline__ void a_ready(const Unit&) const {}
    __device__ __forceinline__ void done(const Unit&) const {}
};
struct BalancedOrder {
    StaticOrder so; int n_long, r_all, r_extra;
    __device__ __forceinline__ void init(int nM_, int nN_, int G_, int c_, int n_long_, int long_cost, int unit_cost) {
        so.init(nM_, nN_, G_, c_); n_long = n_long_;
        int k = (n_long > 0 && n_long < G_) ? long_cost / unit_cost : 0; int ra = (so.nwg - (G_ - n_long) * k) / G_;
        if (k > 0 && ra >= 0 && ra * G_ + (G_ - n_long) * k == so.nwg) { r_all = ra; r_extra = k; } else { r_all = (so.nwg + G_ - 1) / G_; r_extra = 0; n_long = 0; }
    }
    __device__ __forceinline__ bool next(int i, Unit& u) const {
        if (r_extra == 0) return so.next(i, u);
        long L;
        if (i < r_all) L = (long)i * so.G + so.c; else if (so.c >= n_long && i < r_all + r_extra) L = (long)r_all * so.G + (long)(i - r_all) * (so.G - n_long) + (so.c - n_long); else return false;
        if (L >= so.nwg) return false;
        StaticOrder t = so; t.c = 0; t.G = 1; return t.next((int)L, u);
    }
    __device__ __forceinline__ int apos(const Unit& u) const { return u.pm; }
    __device__ __forceinline__ int bpos(const Unit& u) const { return u.pn; }
    __device__ __forceinline__ void a_ready(const Unit&) const {}
    __device__ __forceinline__ void done(const Unit&) const {}
};
struct DynTail {
    unsigned* qh; PG8_LAS int* qw; int r_s; mutable unsigned pend; mutable int last_i;
    __device__ __forceinline__ void init(unsigned* qh_, PG8_LAS int* qw_, int nwg, int G, int tail = 2) { qh = qh_; qw = qw_; const int ra = nwg / G; r_s = ra >= 2 ? (ra - tail > 2 ? ra - tail : 2) : 0x3fffffff; pend = 0u; last_i = 0; }
    __device__ __forceinline__ long pos(int i, int G, int c) const {
        long L = (long)i * G + c;
        if (i >= r_s) L = (long)r_s * G + __builtin_amdgcn_readfirstlane(*qw);
        last_i = i;
        if (i >= r_s - 1 && threadIdx.x == 0) pend = __hip_atomic_fetch_add(qh, 1u, __ATOMIC_RELAXED, __HIP_MEMORY_SCOPE_AGENT);
        return L;
    }
    __device__ __forceinline__ void publish() const { if (last_i >= r_s - 1 && threadIdx.x == 0) *qw = (int)pend; }
};
struct DynOrder {
    StaticOrder so; DynTail dt;
    __device__ __forceinline__ void init(int nM_, int nN_, int G_, int c_, unsigned* qh, PG8_LAS int* qw, int tail) { so.init(nM_, nN_, G_, c_); dt.init(qh, qw, so.nwg, G_, tail); }
    __device__ __forceinline__ bool next(int i, Unit& u) const { return so.at(dt.pos(i, so.G, so.c), u); }
    __device__ __forceinline__ int apos(const Unit& u) const { return u.pm; }
    __device__ __forceinline__ int bpos(const Unit& u) const { return u.pn; }
    __device__ __forceinline__ void a_ready(const Unit&) const { dt.publish(); }
    __device__ __forceinline__ void done(const Unit&) const {}
};
struct MoeOrder {
    StaticOrder so; const PG8_LAS int* tile_e; DynTail dt;
    __device__ __forceinline__ bool next(int i, Unit& u) const { if (!so.at(dt.pos(i, so.G, so.c), u)) return false; u.e = __builtin_amdgcn_readfirstlane(tile_e[u.pm]); return true; }
    __device__ __forceinline__ int apos(const Unit& u) const { return u.pm; }
    __device__ __forceinline__ int bpos(const Unit& u) const { return u.e * so.nN + u.pn; }
    __device__ __forceinline__ void a_ready(const Unit&) const { dt.publish(); }
    __device__ __forceinline__ void done(const Unit&) const {}
};

struct MoeGatherOrder {
    StaticOrder so; const PG8_LAS int* tile_e; const PG8_LAS int* ppad; const PG8_LAS int* ecnt; const int* tokof; PG8_LAS int* tokbuf; DynTail dt;
    __device__ __forceinline__ bool next(int i, Unit& u) const { if (!so.at(dt.pos(i, so.G, so.c), u)) return false; u.e = __builtin_amdgcn_readfirstlane(tile_e[u.pm]);
        u.r0 = 256 * (u.pm - (__builtin_amdgcn_readfirstlane(ppad[u.e]) >> 8)); u.cnt = __builtin_amdgcn_readfirstlane(ecnt[u.e]); return true; }
    __device__ __forceinline__ int apos(const Unit&) const { return 0; }
    __device__ __forceinline__ int bpos(const Unit& u) const { return u.e * so.nN + u.pn; }
    __device__ __forceinline__ void a_ready(const Unit&) const { dt.publish(); }
    __device__ __forceinline__ void done(const Unit&) const {}
};

__device__ __forceinline__ unsigned cvt_pk_bf16(float lo, float hi) { unsigned r; asm volatile("v_cvt_pk_bf16_f32 %0, %1, %2" : "=v"(r) : "v"(lo), "v"(hi)); return r; }

typedef int v8i_t __attribute__((ext_vector_type(8)));
typedef int v4i_t __attribute__((ext_vector_type(4)));
__device__ __forceinline__ f32x4 mfma_f8(bf16x8 b0, bf16x8 b1, bf16x8 a0, bf16x8 a1, f32x4 c) {
    const v4i_t x0 = __builtin_bit_cast(v4i_t, b0), x1 = __builtin_bit_cast(v4i_t, b1), y0 = __builtin_bit_cast(v4i_t, a0), y1 = __builtin_bit_cast(v4i_t, a1);
    const v8i_t X = {x0.x, x0.y, x0.z, x0.w, x1.x, x1.y, x1.z, x1.w}, Y = {y0.x, y0.y, y0.z, y0.w, y1.x, y1.y, y1.z, y1.w};
    return __builtin_amdgcn_mfma_scale_f32_16x16x128_f8f6f4(X, Y, c, 0, 0, 0, 0x7F7F7F7F, 0, 0x7F7F7F7F);
}
__device__ __forceinline__ unsigned pk4_fp8(float a, float b, float c, float d) { int p = __builtin_amdgcn_cvt_pk_fp8_f32(a, b, 0, false); p = __builtin_amdgcn_cvt_pk_fp8_f32(c, d, p, true); return (unsigned)p; }

struct EpiBf16 {
    static constexpr bool PERM = true, AFTER_DRAIN = false, BIAS_DMA = false;
    bf16_t* O; int ldc; const float* bias; int bias_estride; float scale;
    __device__ __forceinline__ void operator()(const f32x4 (&acc)[2][2][4][2], const Unit& u, int wr, int wc, int fr, int fq) const {
        const int row0 = u.pm * BM + wr * 64 + fr; const int col0 = u.pn * BM + wc * 32 + 8 * fq;
        f32x4 bv[2][2];
#pragma unroll
        for (int bj = 0; bj < 2; ++bj)
#pragma unroll
            for (int n = 0; n < 2; ++n) bv[bj][n] = bias ? *(const f32x4*)(bias + (size_t)u.e * bias_estride + col0 + bj * HALF + 4 * n) : (f32x4){0.f, 0.f, 0.f, 0.f};
#pragma unroll
        for (int ai = 0; ai < 2; ++ai)
#pragma unroll
            for (int m = 0; m < 4; ++m) { bf16_t* rowp = O + (size_t)(row0 + ai * HALF + m * 16) * ldc + col0;
#pragma unroll
                for (int bj = 0; bj < 2; ++bj) { const f32x4 v0 = acc[ai][bj][m][0] * scale + bv[bj][0], v1 = acc[ai][bj][m][1] * scale + bv[bj][1];
                    u32x4 w; w.x = cvt_pk_bf16(v0[0], v0[1]); w.y = cvt_pk_bf16(v0[2], v0[3]); w.z = cvt_pk_bf16(v1[0], v1[1]); w.w = cvt_pk_bf16(v1[2], v1[3]);
                    *(u32x4*)(rowp + bj * HALF) = w; } }
    }
};
struct EpiInProj {
    static constexpr bool PERM = true, AFTER_DRAIN = false, BIAS_DMA = false;
    bf16_t* P; bf16_t* PB; int pn_off; float scale;
    __device__ __forceinline__ void operator()(const f32x4 (&acc)[2][2][4][2], const Unit& u, int wr, int wc, int fr, int fq) const {
        const int row0 = u.pm * BM + wr * 64 + fr; const int upn = u.pn + pn_off;
        if (upn < 9) {
            const int col0 = upn * BM + wc * 32 + 8 * fq;
#pragma unroll
            for (int ai = 0; ai < 2; ++ai)
#pragma unroll
                for (int m = 0; m < 4; ++m) { bf16_t* rowp = P + (size_t)(row0 + ai * HALF + m * 16) * 2304 + col0;
#pragma unroll
                    for (int bj = 0; bj < 2; ++bj) { const f32x4 v0 = acc[ai][bj][m][0], v1 = acc[ai][bj][m][1];
                        u32x4 w; w.x = cvt_pk_bf16(v0[0], v0[1]); w.y = cvt_pk_bf16(v0[2], v0[3]); w.z = cvt_pk_bf16(v1[0], v1[1]); w.w = cvt_pk_bf16(v1[2], v1[3]);
                        *(u32x4*)(rowp + bj * HALF) = w; } }
        } else {
            const int cb0 = (upn - 9) * BM, g = cb0 / 1536, rem0 = cb0 % 1536, kind = rem0 / 512, dsh = 2 * g, b = (u.pm * BM) >> 14;
            const int d0 = (32 * wc + 8 * fq) & 63;
#pragma unroll
            for (int bj = 0; bj < 2; ++bj) { const int hh = ((rem0 & 511) + 128 * bj + 32 * wc) >> 6;
                bf16_t* base = PB + ((size_t)((((g * 3 + kind) * 2 + b) * 8 + hh)) << 20) + d0;
#pragma unroll
                for (int ai = 0; ai < 2; ++ai)
#pragma unroll
                    for (int m = 0; m < 4; ++m) { const int s = (row0 + ai * HALF + m * 16) & 16383; const int rr = ((s & ((1 << dsh) - 1)) << (14 - dsh)) + (s >> dsh);
                        const f32x4 v0 = acc[ai][bj][m][0] * scale, v1 = acc[ai][bj][m][1] * scale;
                        u32x4 w; w.x = cvt_pk_bf16(v0[0], v0[1]); w.y = cvt_pk_bf16(v0[2], v0[3]); w.z = cvt_pk_bf16(v1[0], v1[1]); w.w = cvt_pk_bf16(v1[2], v1[3]);
                        *(u32x4*)(base + (size_t)rr * 64) = w; } }
        }
    }
};
struct EpiResidBf16 {
    static constexpr bool PERM = true, AFTER_DRAIN = false, BIAS_DMA = false;
    const float* X; bf16_t* O; int ldc;
    __device__ __forceinline__ void operator()(const f32x4 (&acc)[2][2][4][2], const Unit& u, int wr, int wc, int fr, int fq) const {
        const int row0 = u.pm * BM + wr * 64 + fr; const int col0 = u.pn * BM + wc * 32 + 8 * fq;
#pragma unroll
        for (int ai = 0; ai < 2; ++ai)
#pragma unroll
            for (int m = 0; m < 4; ++m) { const size_t off = (size_t)(row0 + ai * HALF + m * 16) * ldc + col0;
#pragma unroll
                for (int bj = 0; bj < 2; ++bj) { const f32x4 x0 = *(const f32x4*)(X + off + bj * HALF), x1 = *(const f32x4*)(X + off + bj * HALF + 4);
                    const f32x4 v0 = x0 + acc[ai][bj][m][0], v1 = x1 + acc[ai][bj][m][1];
                    u32x4 w; w.x = cvt_pk_bf16(v0[0], v0[1]); w.y = cvt_pk_bf16(v0[2], v0[3]); w.z = cvt_pk_bf16(v1[0], v1[1]); w.w = cvt_pk_bf16(v1[2], v1[3]);
                    *(u32x4*)(O + off + bj * HALF) = w; } }
    }
};
struct EpiFp8 {
    static constexpr bool PERM = true, AFTER_DRAIN = false, BIAS_DMA = true;
    unsigned char* O; int ldc; const float* bias; int bias_estride; float scale; PG8_LAS float* bbuf;
    __device__ __forceinline__ void bias_dma(const Unit& u, int ui, int lane) const {
        __builtin_amdgcn_global_load_lds((const unsigned*)(bias + (size_t)u.e * bias_estride + u.pn * BM + 4 * lane), (PG8_LAS unsigned*)(bbuf + (ui & 1) * 256), 16, 0, 0); }
    __device__ __forceinline__ void operator()(const f32x4 (&acc)[2][2][4][2], const Unit& u, int wr, int wc, int fr, int fq, int ui) const {
        const int row0 = u.pm * BM + wr * 64 + fr; const int col0 = u.pn * BM + wc * 32 + 8 * fq;
        const PG8_LAS float* bb = bbuf + (ui & 1) * 256 + wc * 32 + 8 * fq;
        f32x4 bv[2][2];
#pragma unroll
        for (int bj = 0; bj < 2; ++bj)
#pragma unroll
            for (int n = 0; n < 2; ++n) bv[bj][n] = *(const PG8_LAS f32x4*)(bb + bj * HALF + 4 * n);
#pragma unroll
        for (int ai = 0; ai < 2; ++ai)
#pragma unroll
            for (int m = 0; m < 4; ++m) { unsigned char* rowp = O + (size_t)(row0 + ai * HALF + m * 16) * ldc + col0;
#pragma unroll
                for (int bj = 0; bj < 2; ++bj) { const f32x4 v0 = acc[ai][bj][m][0] * scale + bv[bj][0], v1 = acc[ai][bj][m][1] * scale + bv[bj][1];
                    u32x2 w; w.x = pk4_fp8(v0[0], v0[1], v0[2], v0[3]); w.y = pk4_fp8(v1[0], v1[1], v1[2], v1[3]);
                    *(u32x2*)(rowp + bj * HALF) = w; } }
    }
};
struct EpiSwiglu {
    static constexpr bool PERM = true, AFTER_DRAIN = false, BIAS_DMA = true;
    unsigned char* H; const float* bgu; float scale; PG8_LAS float* bbuf;
    __device__ __forceinline__ void bias_dma(const Unit& u, int ui, int lane) const {
        __builtin_amdgcn_global_load_lds((const unsigned*)(bgu + (size_t)u.e * 4096 + u.pn * HALF + (lane >> 5) * 2048 + 4 * (lane & 31)), (PG8_LAS unsigned*)(bbuf + (ui & 1) * 256), 16, 0, 0); }
    __device__ __forceinline__ float act(float g, float up) const {
        g = fminf(g, 7.0f); up = fminf(fmaxf(up, -7.0f), 7.0f);
        const float sg = __builtin_amdgcn_rcpf(1.0f + __builtin_amdgcn_exp2f(-1.702f * 1.4426950408889634f * g));
        return (up + 1.0f) * g * sg;
    }
    __device__ __forceinline__ void operator()(const f32x4 (&acc)[2][2][4][2], const Unit& u, int wr, int wc, int fr, int fq, int ui) const {
        const int row0 = u.pm * BM + wr * 64 + fr; const int colh = u.pn * HALF + wc * 32 + 8 * fq;
        const PG8_LAS float* bg = bbuf + (ui & 1) * 256 + wc * 32 + 8 * fq;
        const f32x4 bg0 = *(const PG8_LAS f32x4*)(bg), bg1 = *(const PG8_LAS f32x4*)(bg + 4), bu0 = *(const PG8_LAS f32x4*)(bg + 128), bu1 = *(const PG8_LAS f32x4*)(bg + 132);
#pragma unroll
        for (int ai = 0; ai < 2; ++ai)
#pragma unroll
            for (int m = 0; m < 4; ++m) { unsigned char* rowp = H + (size_t)(row0 + ai * HALF + m * 16) * 2048 + colh;
                const f32x4 g0 = acc[ai][0][m][0] * scale + bg0, g1 = acc[ai][0][m][1] * scale + bg1, u0 = acc[ai][1][m][0] * scale + bu0, u1 = acc[ai][1][m][1] * scale + bu1;
                u32x2 w; w.x = pk4_fp8(act(g0[0], u0[0]), act(g0[1], u0[1]), act(g0[2], u0[2]), act(g0[3], u0[3]));
                w.y = pk4_fp8(act(g1[0], u1[0]), act(g1[1], u1[1]), act(g1[2], u1[2]), act(g1[3], u1[3]));
                *(u32x2*)rowp = w; }
    }
};

template <class Epi, class Sched, bool ALIGN_EPI = false, bool SP2 = false, bool F8 = false, bool GATHER = false>
__device__ __forceinline__ void gemm_phase(PG8_LAS unsigned char* lds, const int K, const char* Abase, const char* Bbase, const Sched& S, const Epi& E) {
    const int tid = threadIdx.x, wid = __builtin_amdgcn_readfirstlane(tid >> 6), lane = tid & 63, wr = wid >> 2, wc = wid & 3, fr = lane & 15, fq = lane >> 4;
    const int nt = K / BK;
    static_assert(SP2, "only the two-super-phase loop is kept");
    unsigned voffB[2], vAc[2][2], vAn[2][2]; int RA[2]; unsigned CA2[2];
#pragma unroll
    for (int i = 0; i < 2; ++i) { int R, C; stage_rc(tid * 16 + i * 8192, R, C); const int Rb = Epi::PERM ? ((R & ~31) + perm32(R & 31)) : R;
        RA[i] = R; CA2[i] = (unsigned)C * 2u; voffB[i] = (unsigned)(Rb * K + C) * 2u; }
    const size_t kstep = (size_t)(BK * 2);
    const size_t hstep = (size_t)HALF * K * 2;
    const size_t tstep = 2 * hstep;
#pragma unroll
    for (int h = 0; h < 2; ++h)
#pragma unroll
        for (int i = 0; i < 2; ++i) vAc[h][i] = vAn[h][i] = (unsigned)(RA[i] * K) * 2u + CA2[i] + (unsigned)(h * hstep);
#define PG8_TOKDMA(slot, U) do { if (wid == 0) __builtin_amdgcn_global_load_lds((const unsigned*)(S.tokof + (size_t)(U).e * 32768 + (U).r0 + 4 * lane), (PG8_LAS unsigned*)(S.tokbuf + (slot) * 256), 16, 0, 0); } while (0)
#define PG8_TOKOFF(dst, slot, U) do { const PG8_LAS int* tb_ = S.tokbuf + (slot) * 256; _Pragma("unroll") for (int h_ = 0; h_ < 2; ++h_) _Pragma("unroll") for (int i_ = 0; i_ < 2; ++i_) { \
        const int rk_ = 128 * h_ + RA[i_]; int tk_ = tb_[rk_]; tk_ = ((U).r0 + rk_ < (U).cnt) ? tk_ : 0; dst[h_][i_] = (unsigned)tk_ * (unsigned)(2 * K) + CA2[i_]; } } while (0)
    const unsigned ldsw = (unsigned)wid * 1024u;
    const int aoff = lds_byte(wr * 64 + fr, fq * 8), boff = lds_byte(wc * 32 + fr, fq * 8);
#define PG8_SA(b, h) (((b) * 2 + (h)) * HTB)
#define PG8_SB(b, h) ((4 + (b) * 2 + (h)) * HTB)
#define PG8_STAGE(bufoff, RS, goff, voff) do { _Pragma("unroll") for (int _i = 0; _i < 2; ++_i) \
        __builtin_amdgcn_raw_ptr_buffer_load_lds(RS, (PG8_LAS void*)(lds + (bufoff) + ldsw + _i * 8192), 16, (voff)[_i], (goff), 0, 0); } while (0)
#define PG8_LDA(dst, b, h) do { if constexpr (F8) { _Pragma("unroll") for (int m = 0; m < 4; ++m) { dst##8[m].lo = *(const PG8_LAS v4i_t*)(lds + PG8_SA(b, h) + aoff + m * 2048); dst##8[m].hi = *(const PG8_LAS v4i_t*)(lds + PG8_SA(b, h) + aoff + m * 2048 + 1024); } } \
    else { _Pragma("unroll") for (int m = 0; m < 4; ++m) _Pragma("unroll") for (int k = 0; k < 2; ++k) dst[m][k] = *(const PG8_LAS bf16x8*)(lds + PG8_SA(b, h) + aoff + m * 2048 + k * 1024); } } while (0)
#define PG8_LDB(dst, b, h) do { if constexpr (F8) { _Pragma("unroll") for (int n = 0; n < 2; ++n) { dst##8[n].lo = *(const PG8_LAS v4i_t*)(lds + PG8_SB(b, h) + boff + n * 2048); dst##8[n].hi = *(const PG8_LAS v4i_t*)(lds + PG8_SB(b, h) + boff + n * 2048 + 1024); } } \
    else { _Pragma("unroll") for (int n = 0; n < 2; ++n) _Pragma("unroll") for (int k = 0; k < 2; ++k) dst[n][k] = *(const PG8_LAS bf16x8*)(lds + PG8_SB(b, h) + boff + n * 2048 + k * 1024); } } while (0)
#define PG8_MMA(ai, bj, At, Bt) do { __builtin_amdgcn_s_setprio(1); if constexpr (F8) { _Pragma("unroll") for (int m = 0; m < 4; ++m) _Pragma("unroll") for (int n = 0; n < 2; ++n) \
        asm volatile("v_mfma_f32_16x16x128_f8f6f4 %0, %1, %2, %0" : "+v"(acc[ai][bj][m][n]) : "v"(Bt##8[n]), "v"(At##8[m])); } else { _Pragma("unroll") for (int m = 0; m < 4; ++m) _Pragma("unroll") for (int n = 0; n < 2; ++n) _Pragma("unroll") for (int k = 0; k < 2; ++k) \
        acc[ai][bj][m][n] = __builtin_amdgcn_mfma_f32_16x16x32_bf16(Bt[n][k], At[m][k], acc[ai][bj][m][n], 0, 0, 0); } __builtin_amdgcn_s_setprio(0); } while (0)
#define PG8_WAIT_V(n) asm volatile("s_waitcnt vmcnt(" #n ")" ::: "memory")
#define PG8_WAIT_L(n) asm volatile("s_waitcnt lgkmcnt(" #n ")" ::: "memory")
#define PG8_BAR __builtin_amdgcn_s_barrier()
#define PG8_SCHED __builtin_amdgcn_sched_barrier(0)
    Unit cur, nxt; int ui = 0;
    if (!S.next(0, cur)) return;
    f32x4 acc[2][2][4][2];
#pragma unroll
    for (int a = 0; a < 2; ++a)
#pragma unroll
        for (int b = 0; b < 2; ++b)
#pragma unroll
            for (int m = 0; m < 4; ++m)
#pragma unroll
                for (int n = 0; n < 2; ++n) acc[a][b][m][n] = (f32x4){0.f, 0.f, 0.f, 0.f};
    bf16x8 At[4][2], B0[2][2], B1[2][2]; v8i_t At8[4], B08[2], B18[2];
    const __amdgpu_buffer_rsrc_t rsA = __builtin_amdgcn_make_buffer_rsrc((void*)Abase, 0, 0x7fffffff, 0x00020000), rsB = __builtin_amdgcn_make_buffer_rsrc((void*)Bbase, 0, 0x7fffffff, 0x00020000);
    unsigned cA = (unsigned)((size_t)S.apos(cur) * tstep), cB = (unsigned)((size_t)S.bpos(cur) * tstep);
    S.a_ready(cur);
    if constexpr (GATHER) { PG8_TOKDMA(0, cur); PG8_WAIT_V(0); PG8_BAR; PG8_TOKOFF(vAc, 0, cur); PG8_WAIT_L(0); }
    {
        PG8_STAGE(PG8_SB(0, 0), rsB, cB, voffB); PG8_STAGE(PG8_SB(0, 1), rsB, cB + (unsigned)hstep, voffB); PG8_STAGE(PG8_SA(0, 0), rsA, cA, vAc[0]); PG8_STAGE(PG8_SA(0, 1), rsA, cA, vAc[1]);
        if (wr == 1) PG8_BAR;
        PG8_WAIT_V(2); PG8_BAR;
        PG8_STAGE(PG8_SB(1, 0), rsB, cB + (unsigned)kstep, voffB); PG8_STAGE(PG8_SA(1, 0), rsA, cA + (unsigned)kstep, vAc[0]); PG8_STAGE(PG8_SB(1, 1), rsB, cB + (unsigned)(hstep + kstep), voffB);
        PG8_WAIT_V(6); PG8_BAR;
    }
    for (;;) {
        const bool has_next = S.next(ui + 1, nxt);
        const unsigned nA = has_next ? (unsigned)((size_t)S.apos(nxt) * tstep) : cA; const unsigned nB = has_next ? (unsigned)((size_t)S.bpos(nxt) * tstep) : cB;
        if constexpr (Epi::BIAS_DMA) { if (wid == 1) E.bias_dma(cur, ui, lane); }
        if constexpr (GATHER) { if (has_next) PG8_TOKDMA((ui + 1) & 1, nxt); }
        for (int t = 0; t < nt; t += 2) {
            const bool last = (t == nt - 2);
            const unsigned a1 = cA + (unsigned)((t + 1) * kstep);
            const unsigned a2 = last ? nA : cA + (unsigned)((t + 2) * kstep); const unsigned b2 = last ? nB : cB + (unsigned)((t + 2) * kstep);
            const unsigned a3 = a2 + (unsigned)kstep; const unsigned b3 = b2 + (unsigned)kstep;
            if (last && has_next) S.a_ready(nxt);
            if constexpr (GATHER) { if (last && has_next) { PG8_TOKOFF(vAn, (ui + 1) & 1, nxt); } }
            const unsigned v20 = last ? vAn[0][0] : vAc[0][0], v21 = last ? vAn[0][1] : vAc[0][1], v30 = last ? vAn[1][0] : vAc[1][0], v31 = last ? vAn[1][1] : vAc[1][1];
            const unsigned vx0[2] = {v20, v21}, vx1[2] = {v30, v31};
            PG8_LDB(B0, 0, 0); PG8_LDB(B1, 0, 1); PG8_SCHED; PG8_LDA(At, 0, 0); PG8_STAGE(PG8_SA(1, 1), rsA, a1, vAc[1]);
            PG8_WAIT_V(8); PG8_WAIT_L(0); PG8_BAR; PG8_MMA(0, 0, At, B0); PG8_MMA(0, 1, At, B1); PG8_BAR; PG8_SCHED;
            PG8_LDA(At, 0, 1); PG8_STAGE(PG8_SB(0, 0), rsB, b2, voffB); PG8_STAGE(PG8_SB(0, 1), rsB, b2 + (unsigned)hstep, voffB); PG8_STAGE(PG8_SA(0, 0), rsA, a2, vx0);
            PG8_WAIT_V(8); PG8_WAIT_L(0); PG8_BAR; PG8_MMA(1, 0, At, B0); PG8_MMA(1, 1, At, B1); PG8_BAR; PG8_SCHED;
            PG8_LDB(B0, 1, 0); PG8_LDB(B1, 1, 1); PG8_SCHED; PG8_LDA(At, 1, 0); PG8_STAGE(PG8_SA(0, 1), rsA, a2, vx1);
            PG8_WAIT_V(8); PG8_WAIT_L(0); PG8_BAR; PG8_MMA(0, 0, At, B0); PG8_MMA(0, 1, At, B1); PG8_BAR; PG8_SCHED;
            PG8_LDA(At, 1, 1); PG8_STAGE(PG8_SB(1, 0), rsB, b3, voffB); PG8_STAGE(PG8_SB(1, 1), rsB, b3 + (unsigned)hstep, voffB); PG8_STAGE(PG8_SA(1, 0), rsA, a3, vx0);
            PG8_WAIT_V(8); PG8_WAIT_L(0); PG8_BAR; PG8_MMA(1, 0, At, B0); PG8_MMA(1, 1, At, B1); PG8_BAR; PG8_SCHED;
        }
        if constexpr (F8) { asm volatile("s_nop 15\n\ts_nop 15" ::: "memory"); }
        if constexpr (ALIGN_EPI) { if (wr == 0) PG8_BAR; }
        if constexpr (!Epi::AFTER_DRAIN) { if constexpr (Epi::BIAS_DMA) E(acc, cur, wr, wc, fr, fq, ui); else E(acc, cur, wr, wc, fr, fq); S.done(cur); }
        if (!has_next) break;
#pragma unroll
        for (int a = 0; a < 2; ++a)
#pragma unroll
            for (int b = 0; b < 2; ++b)
#pragma unroll
                for (int m = 0; m < 4; ++m)
#pragma unroll
                    for (int n = 0; n < 2; ++n) acc[a][b][m][n] = (f32x4){0.f, 0.f, 0.f, 0.f};
        cur = nxt; cA = nA; cB = nB; ++ui;
        if constexpr (GATHER) { _Pragma("unroll") for (int h = 0; h < 2; ++h) _Pragma("unroll") for (int i = 0; i < 2; ++i) vAc[h][i] = vAn[h][i]; }
        if constexpr (ALIGN_EPI) { if (wr == 1) PG8_BAR; }
    }
    PG8_WAIT_V(0);
    if constexpr (!ALIGN_EPI) { if (wr == 0) PG8_BAR; }
    PG8_BAR;
    if constexpr (Epi::AFTER_DRAIN) { E.fused(acc, cur, wr, wc, fr, fq, lds, wid, lane); S.done(cur); }
#undef PG8_SA
#undef PG8_SB
#undef PG8_STAGE
#undef PG8_TOKDMA
#undef PG8_TOKOFF
#undef PG8_LDA
#undef PG8_LDB
#undef PG8_MMA
#undef PG8_WAIT_V
#undef PG8_WAIT_L
#undef PG8_BAR
#undef PG8_SCHED
}
}

namespace attn_body {
using bf16=__hip_bfloat16;
using bf16x8=__attribute__((ext_vector_type(8)))short;
using s16x4=__attribute__((ext_vector_type(4)))short;
using f32x16=__attribute__((ext_vector_type(16)))float;
using u32x4=__attribute__((ext_vector_type(4)))unsigned;
constexpr int D=64;
constexpr int NW=8,QBLK=32,QB=QBLK*NW,KVBLK=64;
__device__ __forceinline__ int crow(int r,int hi){return (r&3)+8*(r>>2)+4*hi;}
#define SBAR() __builtin_amdgcn_sched_barrier(0)
__device__ __forceinline__ void cmask(f32x16&p0,f32x16&p1,int jb,int qrel,int hi){
  const float NEG=-INFINITY; int kb=64*jb+4*hi;
  #pragma unroll
  for(int r=0;r<16;++r){int kv=kb+(r&3)+8*(r>>2); if(kv>qrel)p0[r]=NEG; if(kv+32>qrel)p1[r]=NEG;}
}

constexpr int NSLOT=6, SLOTB=8192;
constexpr int LDS_K=0, LDS_V=NSLOT*SLOTB, LDS_WS=2*NSLOT*SLOTB, LDS_OST=LDS_K, LDS_BYTES=LDS_WS+NW*64*4;
constexpr float C2=0.125f*1.4426950408889634f;
__device__ __forceinline__ void glds16(const void*gsrc,unsigned lds_dst){unsigned keep;
  asm volatile("s_mov_b32 %0, m0\n\ts_mov_b32 m0, %2\n\ts_nop 0\n\tglobal_load_lds_dwordx4 %1, off\n\ts_mov_b32 m0, %0":"=&s"(keep):"v"(gsrc),"s"(lds_dst):"memory");}
__device__ __forceinline__ void glds16s(unsigned long long sbase,unsigned voff,unsigned lds_dst){
  asm volatile("s_mov_b32 m0, %2\n\ts_nop 0\n\tglobal_load_lds_dwordx4 %0, %1"::"v"(voff),"s"(sbase),"s"(lds_dst):"memory","m0");}
__device__ __forceinline__ float max3f(float a,float b,float c){float r;asm("v_max3_f32 %0, %1, %2, %3":"=v"(r):"v"(a),"v"(b),"v"(c));return r;}
__device__ __forceinline__ float max2f(float a,float b){float r;asm("v_max_f32_e32 %0, %1, %2":"=v"(r):"v"(a),"v"(b));return r;}
__device__ __forceinline__ float fadd_s(float a,float b){float r;asm("v_add_f32_e32 %0, %1, %2":"=v"(r):"v"(a),"v"(b));return r;}
__device__ __forceinline__ float fsub_s(float a,float b){float r;asm("v_sub_f32_e32 %0, %1, %2":"=v"(r):"v"(a),"v"(b));return r;}
typedef float f32x2_t __attribute__((ext_vector_type(2))); typedef __bf16 bf16x2_t __attribute__((ext_vector_type(2)));
__device__ __forceinline__ unsigned cvtpk_s(float lo,float hi){f32x2_t v={lo,hi};bf16x2_t b=__builtin_convertvector(v,bf16x2_t);return __builtin_bit_cast(unsigned,b);}
#define WAIT_BAR(N) asm volatile("s_waitcnt vmcnt(" #N ") lgkmcnt(0)\n\ts_barrier":::"memory")

__device__ __forceinline__ void qkt(f32x16&p0,f32x16&p1,const char*Kslot,const bf16x8*qr,const f32x16&negm,int r32,int hi){
  const char*kb=Kslot+hi*1024+r32*16;
  #pragma unroll
  for(int d0=0;d0<4;++d0){
    const bf16x8 b0=*reinterpret_cast<const bf16x8*>(kb+d0*2048);
    const bf16x8 b1=*reinterpret_cast<const bf16x8*>(kb+d0*2048+512);
    if(d0==0){p0=__builtin_amdgcn_mfma_f32_32x32x16_bf16(b0,qr[0],negm,0,0,0);p1=__builtin_amdgcn_mfma_f32_32x32x16_bf16(b1,qr[0],negm,0,0,0);}
    else{p0=__builtin_amdgcn_mfma_f32_32x32x16_bf16(b0,qr[d0],p0,0,0,0);p1=__builtin_amdgcn_mfma_f32_32x32x16_bf16(b1,qr[d0],p1,0,0,0);}}
}
typedef __attribute__((address_space(3))) const char* lds_cptr;
typedef short v4i16_t __attribute__((ext_vector_type(4)));
__device__ __forceinline__ void kload8(bf16x8*kf,lds_cptr kp){
  kf[0]=*(const __attribute__((address_space(3))) bf16x8*)(kp);      kf[1]=*(const __attribute__((address_space(3))) bf16x8*)(kp+512);
  kf[2]=*(const __attribute__((address_space(3))) bf16x8*)(kp+2048); kf[3]=*(const __attribute__((address_space(3))) bf16x8*)(kp+2560);
  kf[4]=*(const __attribute__((address_space(3))) bf16x8*)(kp+4096); kf[5]=*(const __attribute__((address_space(3))) bf16x8*)(kp+4608);
  kf[6]=*(const __attribute__((address_space(3))) bf16x8*)(kp+6144); kf[7]=*(const __attribute__((address_space(3))) bf16x8*)(kp+6656);
}
__device__ __forceinline__ void kload2(bf16x8*kf,lds_cptr kp,int j){ kf[2*j]=*(const __attribute__((address_space(3))) bf16x8*)(kp+j*2048); kf[2*j+1]=*(const __attribute__((address_space(3))) bf16x8*)(kp+j*2048+512); }
__device__ __forceinline__ s16x4 vtr(lds_cptr p){ return __builtin_bit_cast(s16x4,__builtin_amdgcn_ds_read_tr16_b64_v4i16((__attribute__((address_space(3))) v4i16_t*)p)); }
__device__ __forceinline__ float rowmax(const f32x16&p0,const f32x16&p1){
  float a=max3f(p0[0],p0[1],p1[0]),b=max3f(p0[2],p0[3],p1[1]);a=max3f(a,p1[2],p1[3]);
  #pragma unroll
  for(int r=4;r<16;r+=4){a=max3f(a,p0[r],p0[r+1]);b=max3f(b,p0[r+2],p0[r+3]);a=max3f(a,p1[r],p1[r+1]);b=max3f(b,p1[r+2],p1[r+3]);}
  const float m=max2f(a,b);
  auto rr=__builtin_amdgcn_permlane32_swap(__float_as_uint(m),__float_as_uint(m),false,false);
  return max2f(__uint_as_float(rr[0]),__uint_as_float(rr[1]));
}
__device__ __forceinline__ void pv(f32x16*o,int vb,bf16x8 pa0,bf16x8 pa1,bf16x8 pa2,bf16x8 pa3){
  #pragma unroll
  for(int d0=0;d0<2;++d0){s16x4 lo[4],hi[4];
    #pragma unroll
    for(int ks=0;ks<4;++ks){
      asm volatile("ds_read_b64_tr_b16 %0,%1 offset:%c2":"=&v"(lo[ks]):"v"(vb),"i"(d0*4096+ks*1024):"memory");
      asm volatile("ds_read_b64_tr_b16 %0,%1 offset:%c2":"=&v"(hi[ks]):"v"(vb),"i"(d0*4096+ks*1024+512):"memory");}
    asm volatile("s_waitcnt lgkmcnt(0)":::"memory");SBAR();
    #define PK(k) (bf16x8){lo[k][0],lo[k][1],lo[k][2],lo[k][3],hi[k][0],hi[k][1],hi[k][2],hi[k][3]}
    o[d0]=__builtin_amdgcn_mfma_f32_32x32x16_bf16(pa0,PK(0),o[d0],0,0,0);
    o[d0]=__builtin_amdgcn_mfma_f32_32x32x16_bf16(pa1,PK(1),o[d0],0,0,0);
    o[d0]=__builtin_amdgcn_mfma_f32_32x32x16_bf16(pa2,PK(2),o[d0],0,0,0);
    o[d0]=__builtin_amdgcn_mfma_f32_32x32x16_bf16(pa3,PK(3),o[d0],0,0,0);
    #undef PK
  }
}

#ifndef ATTN_STORE16
#define ATTN_STORE16(p,v) (*(u32x4*)(p)=(v))
#endif
typedef _Float16 h2_t __attribute__((ext_vector_type(2))); typedef _Float16 h8_t __attribute__((ext_vector_type(8)));
__device__ __forceinline__ unsigned cvtpk_h(float lo,float hi){f32x2_t v={lo,hi};h2_t b=__builtin_convertvector(v,h2_t);return __builtin_bit_cast(unsigned,b);}
__device__ __forceinline__ void pvh(f32x16*o,int vb,bf16x8 pa0,bf16x8 pa1,bf16x8 pa2,bf16x8 pa3){
  #pragma unroll
  for(int d0=0;d0<2;++d0){s16x4 lo[4],hi[4];
    #pragma unroll
    for(int ks=0;ks<4;++ks){
      asm volatile("ds_read_b64_tr_b16 %0,%1 offset:%c2":"=&v"(lo[ks]):"v"(vb),"i"(d0*4096+ks*1024):"memory");
      asm volatile("ds_read_b64_tr_b16 %0,%1 offset:%c2":"=&v"(hi[ks]):"v"(vb),"i"(d0*4096+ks*1024+512):"memory");}
    asm volatile("s_waitcnt lgkmcnt(0)":::"memory");SBAR();
    #define PKH(k) __builtin_bit_cast(h8_t,(bf16x8){lo[k][0],lo[k][1],lo[k][2],lo[k][3],hi[k][0],hi[k][1],hi[k][2],hi[k][3]})
    o[d0]=__builtin_amdgcn_mfma_f32_32x32x16_f16(__builtin_bit_cast(h8_t,pa0),PKH(0),o[d0],0,0,0);
    o[d0]=__builtin_amdgcn_mfma_f32_32x32x16_f16(__builtin_bit_cast(h8_t,pa1),PKH(1),o[d0],0,0,0);
    o[d0]=__builtin_amdgcn_mfma_f32_32x32x16_f16(__builtin_bit_cast(h8_t,pa2),PKH(2),o[d0],0,0,0);
    o[d0]=__builtin_amdgcn_mfma_f32_32x32x16_f16(__builtin_bit_cast(h8_t,pa3),PKH(3),o[d0],0,0,0);
    #undef PKH
  }
}
template<bool FIXED,int THRL,int PQ,int PK,int PV,int PO,int NT> __device__ __forceinline__ void attn_unit(const bf16*Qu,const bf16*__restrict__ Kh,const bf16*__restrict__ Vh,bf16*Ou,char*shm,float mref){
  const int tid=threadIdx.x,lane=tid&63,r32=lane&31,hi=lane>>5; const int wid=__builtin_amdgcn_readfirstlane(tid>>6);

  const bf16*Qw=Qu+(long)(wid*QBLK)*PQ;

  const unsigned lds0=(unsigned)(uintptr_t)shm;
  float*wsf=(float*)(shm+LDS_WS)+wid*64;
  const unsigned kvo=(unsigned)(lane*PK+wid*8)*2u, vvo=(unsigned)((16*(wid&3)+(lane>>2))*PV+(wid>>2)*32+(lane&3)*8)*2u;
  const unsigned long long kb64=((unsigned long long)(unsigned)__builtin_amdgcn_readfirstlane((int)((unsigned long long)(uintptr_t)Kh>>32))<<32)|(unsigned)__builtin_amdgcn_readfirstlane((int)(unsigned)(uintptr_t)Kh);
  const unsigned long long vb64=((unsigned long long)(unsigned)__builtin_amdgcn_readfirstlane((int)((unsigned long long)(uintptr_t)Vh>>32))<<32)|(unsigned)__builtin_amdgcn_readfirstlane((int)(unsigned)(uintptr_t)Vh);
  const unsigned kdst=lds0+LDS_K+wid*1024, vdst=lds0+LDS_V+wid*1024;
  #define DMA_K(t,slot) glds16s(kb64+(unsigned long long)(t)*(KVBLK*PK*2),kvo,(unsigned)__builtin_amdgcn_readfirstlane(kdst+(slot)))
  #define DMA_V(t,slot) glds16s(vb64+(unsigned long long)(t)*(KVBLK*PV*2),vvo,(unsigned)__builtin_amdgcn_readfirstlane(vdst+(slot)))
  const int vb0=(int)(lds0+LDS_V)+((lane>>4)&1)*32+(lane&3)*8+(4*hi+((lane&15)>>2))*64;
  const char*Kbase=shm+LDS_K; bf16x8 kf[8];
  const lds_cptr shm3=(lds_cptr)shm; const lds_cptr kp0=shm3+LDS_K+hi*1024+r32*16; const lds_cptr vp0=shm3+LDS_V+((lane>>4)&1)*32+(lane&3)*8+(4*hi+((lane&15)>>2))*64;
  static_assert(NT>=8 && NT%2==0,"NT");
  DMA_K(0,0);DMA_V(0,0);DMA_K(1,SLOTB);
  bf16x8 qr[4];
  #pragma unroll
  for(int d0=0;d0<4;++d0)qr[d0]=*reinterpret_cast<const bf16x8*>(&Qw[(long)r32*PQ+d0*16+hi*8]);
  float mhat=0.f,l_reg=0.f;f32x16 o[2];o[0]=f32x16{};o[1]=f32x16{};f32x16 negm=f32x16{}; if constexpr(!FIXED){ asm volatile("":"+v"(negm)); } (void)mref; const f32x16 negc={-4.f,-4.f,-4.f,-4.f,-4.f,-4.f,-4.f,-4.f,-4.f,-4.f,-4.f,-4.f,-4.f,-4.f,-4.f,-4.f}; h2_t hs={(_Float16)0.f,(_Float16)0.f},hs2={(_Float16)0.f,(_Float16)0.f};
  #define QK0(C_,KF_,QR_) do{ if constexpr(FIXED){ asm volatile("v_mfma_f32_32x32x16_bf16 %0, %1, %2, -4.0":"=&v"(C_):"v"(KF_),"v"(QR_)); } else { C_=__builtin_amdgcn_mfma_f32_32x32x16_bf16(KF_,QR_,negm,0,0,0); } }while(0)
  #define NEGM (FIXED?negc:negm)
  const int qrel=wid*QBLK+r32;
  #define CMASK(P0,P1,t) do{}while(0)
  bool resc=false;
  #define START(P0,P1) do{ resc=false; if constexpr(!FIXED){ const float rm=rowmax(P0,P1); \
      const float dl=rm; mhat=fadd_s(mhat,dl); \
      _Pragma("unroll") for(int r=0;r<16;++r){P0[r]=fsub_s(P0[r],dl);P1[r]=fsub_s(P1[r],dl);} \
      _Pragma("unroll") for(int r=0;r<16;++r)negm[r]=-mhat; asm volatile("":"+v"(negm)); } \
    _Pragma("unroll") for(int r=0;r<16;++r)P0[r]=__builtin_amdgcn_exp2f(P0[r]); }while(0)
  #define RESC() do{ if constexpr(!FIXED) if(resc){ asm volatile("s_waitcnt lgkmcnt(0)":::"memory"); \
      _Pragma("unroll") for(int d_=0;d_<2;++d_) _Pragma("unroll") for(int r=0;r<16;++r)o[d_][r]*=wsf[crow(r,hi)]; } }while(0)
  f32x16 pA0,pA1,pB0,pB1;
  int s_m3=4*SLOTB,s_m1=0,s_p1=2*SLOTB;
  #define ROT1(x) x=((x)==(NSLOT-1)*SLOTB)?0:(x)+SLOTB
  #define ROT() do{ROT1(s_m3);ROT1(s_m1);ROT1(s_p1);}while(0)
  WAIT_BAR(0);
  DMA_K(2,2*SLOTB);DMA_K(3,3*SLOTB);DMA_V(1,SLOTB);DMA_K(4,4*SLOTB);DMA_K(5,5*SLOTB);DMA_V(2,2*SLOTB);DMA_V(3,3*SLOTB);
  qkt(pA0,pA1,Kbase,qr,NEGM,r32,hi);asm volatile("s_nop 15\n\ts_nop 7":"+v"(pA0),"+v"(pA1));CMASK(pA0,pA1,0);
  START(pA0,pA1);
  _Pragma("unroll") for(int r=0;r<16;++r)pA1[r]=__builtin_amdgcn_exp2f(pA1[r]);
  WAIT_BAR(4);
  kload8(kf,kp0+SLOTB);
  WAIT_BAR(4);
  s16x4 vlo[8],vhi[8]; u32x4 pw0,pw1,pw2,pw3; pw3=(u32x4){0u,0u,0u,0u};
  #define PKW(P,B) (FIXED?cvtpk_h(P[B],P[B+1]):cvtpk_s(P[B],P[B+1]))
  #define PVMF(A_,B_,C_) (FIXED?__builtin_amdgcn_mfma_f32_32x32x16_f16(__builtin_bit_cast(h8_t,A_),__builtin_bit_cast(h8_t,B_),C_,0,0,0):__builtin_amdgcn_mfma_f32_32x32x16_bf16(A_,B_,C_,0,0,0))
  #define HSUM(E_) do{ if constexpr(FIXED){ hs=hs+__builtin_bit_cast(h2_t,(unsigned)(E_)); } }while(0)
  #define HSUM2(E_) do{ if constexpr(FIXED){ hs2=hs2+__builtin_bit_cast(h2_t,(unsigned)(E_)); } }while(0)
  #define PAF(k) __builtin_bit_cast(bf16x8,pw##k)
  #define VFR(i) (bf16x8){vlo[i][0],vlo[i][1],vlo[i][2],vlo[i][3],vhi[i][0],vhi[i][1],vhi[i][2],vhi[i][3]}
  #define PIN(x) asm volatile("":"+v"(x))
  #define MX3(a,b,c) __builtin_fmaxf(__builtin_fmaxf((a),(b)),(c))
  #define PINF(PW) do{ if constexpr(FIXED){ PIN(PW); } }while(0)
  #define GAPA(MF,A0,A1,A2,A3,W0,W1,PW,HP,E0,E1,PP) do{ MF; if(HP){ PINF(PP); } if constexpr(!FIXED){ sacc+=A0; sacc+=A1; sacc+=A2; sacc+=A3; PIN(sacc); W0; W1; PIN(PW); } else { if(HP){ HSUM(E0); HSUM2(E1); } W0; W1; if(HP){ PIN(hs); PIN(hs2); } } SBAR(); }while(0)
  #define GAPA0(MF,A0,A1,A2,A3,W0,W1,PW,FL_) do{ MF; if constexpr(!FIXED){ sacc+=A0; sacc+=A1; sacc+=A2; sacc+=A3; PIN(sacc); W0; W1; PIN(PW); } else { PIN(pw3); HSUM(pw3[2]); HSUM2(pw3[3]); \
      if(FL_){ hs=hs+hs2; l_reg=__builtin_amdgcn_fdot2(hs,(h2_t){(_Float16)1.f,(_Float16)1.f},l_reg,false); PIN(l_reg);        hs=(h2_t){(_Float16)0.f,(_Float16)0.f}; hs2=hs; } W0; W1; PIN(hs); PIN(hs2); } SBAR(); }while(0)
  #define EX(v) __builtin_amdgcn_exp2f(v)
  #define GAPB(MF,X,B) do{ MF; X[B]=EX(X[B]); X[B+1]=EX(X[B+1]); X[B+2]=EX(X[B+2]); X[B+3]=EX(X[B+3]); PIN(X); SBAR(); }while(0)
  #define VRD(i) do{ vlo[i]=vtr(vp_+(((i)>>2)*4096+((i)&3)*1024)); vhi[i]=vtr(vp_+(((i)>>2)*4096+((i)&3)*1024+512)); }while(0)
  #define KRD(G,j) do{ if(G){ kload2(kf,kp0+sp1_,j); SBAR(); } }while(0)
  #define STEPS(C0,C1,P0,P1,t,GK,GV,GL,FL,SM1,SM3,SP1) do{ SBAR(); const int sp1_=(SP1); \
    const lds_cptr vp_=vp0+(SM1); \
    VRD(0); SBAR(); float sacc=0.f; if constexpr(!FIXED){ sacc=(P0[0]+P0[1]); } \
    GAPA0(QK0(C0,kf[0],qr[0]), P0[2],P0[3],P0[4],P0[5],     pw0[0]=PKW(P0,0), pw0[1]=PKW(P0,2), pw0, FL); \
    VRD(4); SBAR(); GAPA(QK0(C1,kf[1],qr[0]), P0[6],P0[7],P0[8],P0[9],     pw0[2]=PKW(P0,4), pw0[3]=PKW(P0,6), pw0, true, pw0[0], pw0[1], pw0); \
    VRD(1); SBAR(); GAPA(C0=__builtin_amdgcn_mfma_f32_32x32x16_bf16(kf[2],qr[1],C0,0,0,0),   P0[10],P0[11],P0[12],P0[13], pw1[0]=PKW(P0,8), pw1[1]=PKW(P0,10), pw1, true, pw0[2], pw0[3], pw0); \
    VRD(5); SBAR(); GAPA(C1=__builtin_amdgcn_mfma_f32_32x32x16_bf16(kf[3],qr[1],C1,0,0,0),   P0[14],P0[15],P1[0],P1[1],   pw1[2]=PKW(P0,12), pw1[3]=PKW(P0,14), pw1, true, pw1[0], pw1[1], pw1); \
    VRD(2); SBAR(); GAPA(C0=__builtin_amdgcn_mfma_f32_32x32x16_bf16(kf[4],qr[2],C0,0,0,0),   P1[2],P1[3],P1[4],P1[5],     pw2[0]=PKW(P1,0), pw2[1]=PKW(P1,2), pw2, true, pw1[2], pw1[3], pw1); \
    VRD(6); SBAR(); GAPA(C1=__builtin_amdgcn_mfma_f32_32x32x16_bf16(kf[5],qr[2],C1,0,0,0),   P1[6],P1[7],P1[8],P1[9],     pw2[2]=PKW(P1,4), pw2[3]=PKW(P1,6), pw2, true, pw2[0], pw2[1], pw2); \
    VRD(3); SBAR(); GAPA(C0=__builtin_amdgcn_mfma_f32_32x32x16_bf16(kf[6],qr[3],C0,0,0,0),   P1[10],P1[11],P1[12],P1[13], pw3[0]=PKW(P1,8), pw3[1]=PKW(P1,10), pw3, true, pw2[2], pw2[3], pw2); \
    VRD(7); SBAR(); GAPA(C1=__builtin_amdgcn_mfma_f32_32x32x16_bf16(kf[7],qr[3],C1,0,0,0),   P1[14],P1[15],0.f,0.f,       pw3[2]=PKW(P1,12), pw3[3]=PKW(P1,14), pw3, true, pw3[0], pw3[1], pw3); \
    if constexpr(!FIXED){ l_reg+=sacc; } \
    if(GK){DMA_K((t)+5,(SM1));} if(GV){DMA_V((t)+3,(SM3));} \
    CMASK(C0,C1,t); \
    if constexpr(!FIXED){ float a=MX3(C0[0],C0[1],C1[0]),b=MX3(C0[2],C0[3],C1[1]); a=MX3(a,C1[2],C1[3]); \
      _Pragma("unroll") for(int r=4;r<16;r+=4){a=MX3(a,C0[r],C0[r+1]);b=MX3(b,C0[r+2],C0[r+3]);a=MX3(a,C1[r],C1[r+1]);b=MX3(b,C1[r+2],C1[r+3]);} \
      float rm=__builtin_fmaxf(a,b); { auto rr=__builtin_amdgcn_permlane32_swap(__float_as_uint(rm),__float_as_uint(rm),false,false); rm=__builtin_fmaxf(__uint_as_float(rr[0]),__uint_as_float(rr[1])); } \
      resc=false; \
      if(__builtin_expect(__any(rm>(float)THRL),0)){ const float dl=__builtin_fmaxf(rm,0.f); mhat+=dl; \
        _Pragma("unroll") for(int r=0;r<16;++r){C0[r]-=dl;C1[r]-=dl;} \
        _Pragma("unroll") for(int r=0;r<16;++r)negm[r]=-mhat; asm volatile("":"+v"(negm)); \
        const float f=__builtin_amdgcn_exp2f(-dl); l_reg*=f; if(hi==0)wsf[r32]=f; resc=true; } } \
    SBAR(); \
    GAPB(o[0]=PVMF(PAF(0),VFR(0),o[0]), C0,0); \
    GAPB(o[1]=PVMF(PAF(0),VFR(4),o[1]), C0,4); \
    KRD(GL,0); GAPB(o[0]=PVMF(PAF(1),VFR(1),o[0]), C0,8); \
    KRD(GL,1); GAPB(o[1]=PVMF(PAF(1),VFR(5),o[1]), C0,12); \
    KRD(GL,2); GAPB(o[0]=PVMF(PAF(2),VFR(2),o[0]), C1,0); \
    KRD(GL,3); GAPB(o[1]=PVMF(PAF(2),VFR(6),o[1]), C1,4); \
    GAPB(o[0]=PVMF(PAF(3),VFR(3),o[0]), C1,8); \
    GAPB(o[1]=PVMF(PAF(3),VFR(7),o[1]), C1,12); \
    }while(0)
  #define STEP(C0,C1,P0,P1,t,GK,GV,GL,FL) STEPS(C0,C1,P0,P1,t,GK,GV,GL,FL,s_m1,s_m3,s_p1)
  #define SC(k) ((k)*SLOTB)
  int t=1;
  #undef CMASK
  #define CMASK(P0,P1,t) do{}while(0)
  for(;t+10<NT;t+=6){
    STEPS(pB0,pB1,pA0,pA1,t,  true,true,true,true, SC(0),SC(4),SC(2));   RESC();
    STEPS(pA0,pA1,pB0,pB1,t+1,true,true,true,false,SC(1),SC(5),SC(3));   WAIT_BAR(4); RESC();
    STEPS(pB0,pB1,pA0,pA1,t+2,true,true,true,true, SC(2),SC(0),SC(4));   RESC();
    STEPS(pA0,pA1,pB0,pB1,t+3,true,true,true,false,SC(3),SC(1),SC(5));   WAIT_BAR(4); RESC();
    STEPS(pB0,pB1,pA0,pA1,t+4,true,true,true,true, SC(4),SC(2),SC(0));   RESC();
    STEPS(pA0,pA1,pB0,pB1,t+5,true,true,true,false,SC(5),SC(3),SC(1));   WAIT_BAR(4); RESC();
  }
  for(;t+7<NT;t+=2){
    STEP(pB0,pB1,pA0,pA1,t,true,true,true,true);     RESC(); ROT();
    STEP(pA0,pA1,pB0,pB1,t+1,true,true,true,false);   WAIT_BAR(4); RESC(); ROT();
  }
  #undef CMASK
  #define CMASK(P0,P1,t) do{}while(0)
  #define ENDW(tt) do{ if((tt)+6<NT){WAIT_BAR(4);} else if((tt)+4<NT){WAIT_BAR(2);} else {WAIT_BAR(0);} }while(0)
  for(;t+1<NT;t+=2){
    STEP(pB0,pB1,pA0,pA1,t,(t+5<NT),(t+3<NT),(t+1<NT),true);       RESC(); ROT();
    STEP(pA0,pA1,pB0,pB1,t+1,(t+6<NT),(t+4<NT),(t+2<NT),false);     ENDW(t); RESC(); ROT();
  }
  STEP(pB0,pB1,pA0,pA1,NT-1,false,false,false,true); RESC();
  { if constexpr(!FIXED){ float sacc=pB0[0]+pB0[1]; _Pragma("unroll") for(int r=2;r<16;++r)sacc+=pB0[r]; _Pragma("unroll") for(int r=0;r<16;++r)sacc+=pB1[r]; l_reg+=sacc; }
    if constexpr(FIXED){ HSUM(pw3[2]); HSUM2(pw3[3]); }
    pw0=(u32x4){PKW(pB0,0),PKW(pB0,2),PKW(pB0,4),PKW(pB0,6)};pw1=(u32x4){PKW(pB0,8),PKW(pB0,10),PKW(pB0,12),PKW(pB0,14)};pw2=(u32x4){PKW(pB1,0),PKW(pB1,2),PKW(pB1,4),PKW(pB1,6)};pw3=(u32x4){PKW(pB1,8),PKW(pB1,10),PKW(pB1,12),PKW(pB1,14)};
    if constexpr(FIXED){ _Pragma("unroll") for(int q_=0;q_<4;++q_){ HSUM(pw0[q_]); HSUM2(pw1[q_]); HSUM(pw2[q_]); HSUM2(pw3[q_]); } hs=hs+hs2; l_reg=__builtin_amdgcn_fdot2(hs,(h2_t){(_Float16)1.f,(_Float16)1.f},l_reg,false); }
    const int sl_last=(s_m1==(NSLOT-1)*SLOTB)?0:s_m1+SLOTB;
    SBAR(); if constexpr(FIXED) pvh(o,vb0+sl_last,PAF(0),PAF(1),PAF(2),PAF(3)); else pv(o,vb0+sl_last,PAF(0),PAF(1),PAF(2),PAF(3)); }
  #undef PKW
  #undef PVMF
  #undef HSUM
  #undef HSUM2
  #undef PAF
  #undef VFR
  #undef PIN
  #undef MX3
  #undef GAPA
  #undef GAPA0
  #undef PINF
  #undef GAPB
  #undef EX
  #undef VRD
  #undef KRD
  #undef STEP
  #undef STEPS
  #undef SC
  #undef ENDW
  {auto rr=__builtin_amdgcn_permlane32_swap(__float_as_uint(l_reg),__float_as_uint(l_reg),false,false);l_reg=__uint_as_float(rr[0])+__uint_as_float(rr[1]);}
  if(hi==0)wsf[32+r32]=l_reg;asm volatile("s_waitcnt lgkmcnt(0)":::"memory");
  float rli[16];
  #pragma unroll
  for(int r=0;r<16;++r)rli[r]=__builtin_amdgcn_rcpf(wsf[32+crow(r,hi)]);
  bf16*Ow=Ou+(long)(wid*QBLK)*PO;
  { bf16*stg=(bf16*)(shm+LDS_OST)+wid*2048;
    #pragma unroll
    for(int r=0;r<16;++r){const int orow=crow(r,hi);
      #pragma unroll
      for(int d0=0;d0<2;++d0)stg[orow*64+d0*32+r32]=__float2bfloat16(o[d0][r]*rli[r]);}
    asm volatile("s_waitcnt lgkmcnt(0)":::"memory");
    #pragma unroll
    for(int i=0;i<4;++i){const int row=i*8+(lane>>3),ch=lane&7; const u32x4 v=*(const u32x4*)(stg+row*64+ch*8); ATTN_STORE16(Ow+(long)row*PO+ch*8,v);} }
  asm volatile("s_waitcnt lgkmcnt(0)\n\ts_barrier":::"memory");
  #undef DMA_K
  #undef DMA_V
  #undef CMASK
  #undef START
  #undef NEGM
  #undef QK0
  #undef RESC
  #undef ROT
  #undef ROT1
}

constexpr int SEQ_=16384, INW_=6912, MTOK_=2*SEQ_;
constexpr int B_LDS_K=0, B_LDS_V=49152, B_LDS_WS=98304, B_LDS_BYTES=98304+2048;
__device__ __forceinline__ void attnb_phase(int u0,int ustep,const bf16*P,bf16*Ob,float*Lse,char*shm,unsigned*qhead){
  int tid_=threadIdx.x; asm volatile("":"+v"(tid_));
  const int tid=tid_,lane=tid&63,r32=lane&31,hi=lane>>5; const int wid=__builtin_amdgcn_readfirstlane(tid>>6);
  const unsigned lds0=(unsigned)(uintptr_t)shm;
  float*wsf=(float*)(shm+B_LDS_WS)+wid*64;
  const float C2=0.125f*1.4426950408889634f;
  const int jt0=wid>>1;
  const float ltf=(float)(4*hi-r32-32*(wid&1)-64);
  const int vb0=(int)(lds0+B_LDS_V)+((lane>>4)&1)*32+(lane&3)*8+(4*hi+((lane&15)>>2))*64;
  #define BDEC(u_,b_,g_,h_,dil_,r_,qb_) do{ g_=(u_)>>10; const int rem_=(u_)&1023; b_=rem_>>9; h_=(rem_>>6)&7; const int rq_=rem_&63, dsh_=2*g_; dil_=1<<dsh_; r_=rq_>>(6-dsh_); qb_=rq_&((64>>dsh_)-1); }while(0)
  #define BBASE(kind_,b_,g_,h_,dil_,r_) (P+((size_t)(((((g_)*3+(kind_))*2+(b_))*8+(h_)))<<20)+(size_t)(r_)*(SEQ_/(dil_))*64)
  #define BDMA_K(b_,g_,h_,dil_,r_,qb_) do{ int ln_=lane; asm volatile("":"+v"(ln_)); const int L_=SEQ_/(dil_); const bf16*Pb_=BBASE(1,b_,g_,h_,dil_,r_); const int kb_=(qb_)*256-64; \
      _Pragma("unroll") for(int j=0;j<6;++j){ int ik=kb_+64*j+ln_; ik=ik<0?0:(ik>=L_?L_-1:ik); \
        glds16(Pb_+(size_t)ik*64+wid*8,(unsigned)__builtin_amdgcn_readfirstlane(lds0+B_LDS_K+j*8192+wid*1024)); } }while(0)
  #define BDMA_V(b_,g_,h_,dil_,r_,qb_) do{ int ln_=lane; asm volatile("":"+v"(ln_)); const int L_=SEQ_/(dil_); const bf16*Pb_=BBASE(2,b_,g_,h_,dil_,r_); const int kb_=(qb_)*256-64; \
      _Pragma("unroll") for(int j=0;j<6;++j){ int iv=kb_+64*j+16*(wid&3)+(ln_>>2); iv=iv<0?0:(iv>=L_?L_-1:iv); \
        glds16(Pb_+(size_t)iv*64+(wid>>2)*32+(ln_&3)*8,(unsigned)__builtin_amdgcn_readfirstlane(lds0+B_LDS_V+j*8192+wid*1024)); } }while(0)
  #define BLOAD_Q(Q_,b_,g_,h_,dil_,r_,qb_) do{ int ln_=lane; asm volatile("":"+v"(ln_)); const bf16*qp_=BBASE(0,b_,g_,h_,dil_,r_)+(size_t)((qb_)*256+wid*32+(ln_&31))*64+(ln_>>5)*8; \
      _Pragma("unroll") for(int d0=0;d0<4;++d0)Q_[d0]=*reinterpret_cast<const bf16x8*>(qp_+d0*16); }while(0)
  int u=u0; if(u>=3072)return;
  int*nxw=(int*)(shm+B_LDS_WS);
  if(tid==0){ const unsigned t_=__hip_atomic_fetch_add(qhead,1u,__ATOMIC_RELAXED,__HIP_MEMORY_SCOPE_AGENT); *nxw=ustep+(int)t_; }
  int b,g,h,dil,r,qb; BDEC(u,b,g,h,dil,r,qb);
  bf16x8 qn[4];
  BDMA_K(b,g,h,dil,r,qb); BLOAD_Q(qn,b,g,h,dil,r,qb);
  for(;;){
    asm volatile("":"+v"(qn[0]),"+v"(qn[1]),"+v"(qn[2]),"+v"(qn[3]));
    asm volatile("s_waitcnt vmcnt(0)\n\ts_barrier":::"memory");
    BDMA_V(b,g,h,dil,r,qb);
    const int L=SEQ_/dil, kb_i=qb*256-64, iq=qb*256+wid*32+r32;
    f32x16 s0a,s0b,s1a,s1b,s2a,s2b; const f32x16 zz=f32x16{};
    qkt(s0a,s0b,shm+B_LDS_K+(jt0+0)*8192,qn,zz,r32,hi);
    qkt(s1a,s1b,shm+B_LDS_K+(jt0+1)*8192,qn,zz,r32,hi);
    qkt(s2a,s2b,shm+B_LDS_K+(jt0+2)*8192,qn,zz,r32,hi);
    asm volatile("s_waitcnt lgkmcnt(0)\n\ts_barrier":::"memory");
    const int un=__builtin_amdgcn_readfirstlane(*nxw); const bool has_next=un<3072;
    unsigned tk_=0u; if(tid==0&&has_next){ tk_=__hip_atomic_fetch_add(qhead,1u,__ATOMIC_RELAXED,__HIP_MEMORY_SCOPE_AGENT); }
    int nb=b,ng=g,nh=h,ndil=dil,nr=r,nqb=qb;
    if(has_next){ BDEC(un,nb,ng,nh,ndil,nr,nqb); BDMA_K(nb,ng,nh,ndil,nr,nqb); BLOAD_Q(qn,nb,ng,nh,ndil,nr,nqb); }
    const float slope2=__builtin_ldexpf(1.4426950408889634f*(float)dil,-(h+1));
    float mx=-INFINITY;
    float lt=ltf; asm volatile("":"+v"(lt));
    if(kb_i>=0&&kb_i+384<=L){
      #define BMASKF(S0,S1,tt) do{ _Pragma("unroll") for(int rr=0;rr<16;++rr){ \
          { const float t_=lt+(float)(64*(tt)+(rr&3)+8*(rr>>2)); const float v_=__builtin_fmaf(S0[rr],C2,-slope2*__builtin_fabsf(t_)); S0[rr]=(__builtin_fabsf(t_)<=64.0f)?v_:-INFINITY; mx=__builtin_fmaxf(mx,S0[rr]); } \
          { const float t_=lt+(float)(64*(tt)+(rr&3)+8*(rr>>2)+32); const float v_=__builtin_fmaf(S1[rr],C2,-slope2*__builtin_fabsf(t_)); S1[rr]=(__builtin_fabsf(t_)<=64.0f)?v_:-INFINITY; mx=__builtin_fmaxf(mx,S1[rr]); } } }while(0)
      BMASKF(s0a,s0b,0); BMASKF(s1a,s1b,1); BMASKF(s2a,s2b,2);
      #undef BMASKF
    } else {
      #define BMASK(S0,S1,tt) do{ _Pragma("unroll") for(int rr=0;rr<16;++rr){ const int ik0=kb_i+64*(jt0+(tt))+crow(rr,hi); \
          { const int jj=ik0-iq; const int aj=jj<0?-jj:jj; const bool ok=(aj<=64)&&(ik0>=0)&&(ik0<L); S0[rr]=ok?(S0[rr]*C2-slope2*(float)aj):-INFINITY; mx=__builtin_fmaxf(mx,S0[rr]); } \
          { const int ik1=ik0+32; const int jj=ik1-iq; const int aj=jj<0?-jj:jj; const bool ok=(aj<=64)&&(ik1>=0)&&(ik1<L); S1[rr]=ok?(S1[rr]*C2-slope2*(float)aj):-INFINITY; mx=__builtin_fmaxf(mx,S1[rr]); } } }while(0)
      BMASK(s0a,s0b,0); BMASK(s1a,s1b,1); BMASK(s2a,s2b,2);
      #undef BMASK
    }
    { auto rr=__builtin_amdgcn_permlane32_swap(__float_as_uint(mx),__float_as_uint(mx),false,false); mx=__builtin_fmaxf(__uint_as_float(rr[0]),__uint_as_float(rr[1])); }
    float l=0.f;
    #define BEXP(S) do{ _Pragma("unroll") for(int rr=0;rr<16;++rr){ S[rr]=__builtin_amdgcn_exp2f(S[rr]-mx); l+=S[rr]; } }while(0)
    BEXP(s0a);BEXP(s0b);BEXP(s1a);BEXP(s1b);BEXP(s2a);BEXP(s2b);
    #undef BEXP
    { auto rr=__builtin_amdgcn_permlane32_swap(__float_as_uint(l),__float_as_uint(l),false,false); l=__uint_as_float(rr[0])+__uint_as_float(rr[1]); }
    if(has_next){ asm volatile("s_waitcnt vmcnt(10)\n\ts_barrier":::"memory"); } else { asm volatile("s_waitcnt vmcnt(0)\n\ts_barrier":::"memory"); }
    if(tid==0&&has_next){ *nxw=ustep+(int)tk_; }
    f32x16 o[2]; o[0]=f32x16{}; o[1]=f32x16{};
    #define PKW(P_,B_) cvtpk_s(P_[B_],P_[B_+1])
    #define BPV(SA,SB,tt) do{ u32x4 w0=(u32x4){PKW(SA,0),PKW(SA,2),PKW(SA,4),PKW(SA,6)},w1=(u32x4){PKW(SA,8),PKW(SA,10),PKW(SA,12),PKW(SA,14)},w2=(u32x4){PKW(SB,0),PKW(SB,2),PKW(SB,4),PKW(SB,6)},w3=(u32x4){PKW(SB,8),PKW(SB,10),PKW(SB,12),PKW(SB,14)}; \
        pv(o,vb0+(jt0+(tt))*8192,__builtin_bit_cast(bf16x8,w0),__builtin_bit_cast(bf16x8,w1),__builtin_bit_cast(bf16x8,w2),__builtin_bit_cast(bf16x8,w3)); }while(0)
    BPV(s0a,s0b,0); BPV(s1a,s1b,1); BPV(s2a,s2b,2);
    #undef BPV
    #undef PKW
    { int rl_=r32; asm volatile("":"+v"(rl_)); if(hi==0)wsf[32+rl_]=l; }
    asm volatile("s_waitcnt lgkmcnt(0)\n\ts_barrier":::"memory");
    float rli[16];
    #pragma unroll
    for(int rr=0;rr<16;++rr)rli[rr]=__builtin_amdgcn_rcpf(wsf[32+crow(rr,hi)]);
    const size_t orow0=(size_t)g*MTOK_+(size_t)b*SEQ_;
    { bf16*stg=(bf16*)(shm+B_LDS_V)+wid*2048;
      #pragma unroll
      for(int rr=0;rr<16;++rr){const int orow=crow(rr,hi);
        #pragma unroll
        for(int d0=0;d0<2;++d0)stg[orow*64+d0*32+r32]=__float2bfloat16(o[d0][rr]*rli[rr]);}
      asm volatile("s_waitcnt lgkmcnt(0)":::"memory");
      #pragma unroll
      for(int i=0;i<4;++i){const int row=i*8+(lane>>3),ch=lane&7; const u32x4 v=*(const u32x4*)(stg+row*64+ch*8);
        const int tok=r+dil*(qb*256+wid*32+row); *(u32x4*)(Ob+(orow0+tok)*512+h*64+ch*8)=v;} }
    if(hi==0){ const int tok=r+dil*iq; Lse[(orow0+tok)*8+h]=mx+__builtin_amdgcn_logf(l); }
    asm volatile("s_waitcnt lgkmcnt(0)":::"memory");
    if(!has_next)break;
    u=un; b=nb; g=ng; h=nh; dil=ndil; r=nr; qb=nqb;
  }
  asm volatile("s_waitcnt vmcnt(0) lgkmcnt(0)\n\ts_barrier":::"memory");
  #undef BDEC
  #undef BBASE
  #undef BDMA_K
  #undef BDMA_V
  #undef BLOAD_Q
}
#undef SBAR
#undef WAIT_BAR
}

constexpr int NWAVES = 8;
constexpr int BATCH = 2, SEQ = 16384, DM = 2048, MTOK = BATCH * SEQ;
constexpr int AQW = 1536, AKVW = 384, INW = 6912, BW = 512;
constexpr int NE = 32, TOPK = 4;
constexpr int CAP_ROWS = MTOK * TOPK + NE * 256;
constexpr float NORM_EPS = 1e-5f, QK_EPS = 1e-6f;
constexpr int N_PHASES = 11;

constexpr size_t MiB = 1u << 20;
constexpr size_t WS_CTL = 0, CTL_ZERO_BYTES = 128 * 1024;
constexpr size_t WS_ROPE = 1 * MiB;
constexpr size_t WS_WRT  = 2 * MiB;
constexpr size_t WS_WIN  = 3 * MiB;
constexpr size_t WS_WOUT = 30 * MiB;
constexpr size_t WS_WGU  = 38 * MiB;
constexpr size_t WS_WD   = 550 * MiB;
constexpr size_t WS_HN   = 806 * MiB;
constexpr size_t WS_P    = 934 * MiB;
constexpr size_t WS_QN   = 1366 * MiB;
constexpr size_t WS_KN   = 1462 * MiB;
constexpr size_t WS_OA   = 1486 * MiB;
constexpr size_t WS_OB   = 1582 * MiB;
constexpr size_t WS_LSE  = 1678 * MiB;
constexpr size_t WS_MG   = 1682 * MiB;
constexpr size_t WS_X1   = 1810 * MiB;
constexpr size_t WS_EIDX = 2066 * MiB;
constexpr size_t WS_RANK = 2067 * MiB;
constexpr size_t WS_GATE = 2068 * MiB;
constexpr size_t WS_XG   = 2070 * MiB;
constexpr size_t WS_H    = 2614 * MiB;
constexpr size_t WS_VN   = 3158 * MiB;
constexpr size_t WS_TOKOF = 3182 * MiB;
constexpr size_t WS_END  = 3186 * MiB;
static_assert(WS_XG + (size_t)CAP_ROWS * 2048 * 2 <= WS_H && WS_H + (size_t)CAP_ROWS * 2048 * 2 <= WS_VN, "ws map");
constexpr int CW_TMO = 0, CW_CODE = 1;
constexpr int CW_BAR = 4096;
constexpr int CW_CNT = 16384;
constexpr int CW_Q8 = 16384 + 160, CW_Q9 = 16384 + 192, CW_Q1 = 16384 + 224, CW_Q5 = 16384 + 256;
constexpr int CW_QB = 16384 + 128;
constexpr int CW_VMAX = 16384 + 64;

constexpr int RING_OFF = 0, RING_BYTES = 131072;
constexpr int LDSCTL_OFF = RING_BYTES, MISC_OFF = LDSCTL_OFF + 320;
constexpr int TBL_OFF = 131584;
constexpr int PP_OFF = 134144;
constexpr int QW_OFF = 134304;
constexpr int CNT_OFF = 134400;
constexpr int ROUTE_OFF = 134656;
constexpr int LOGIT_OFF = 138752;
constexpr int LDS_BYTES = 147456;
static_assert(LOGIT_OFF + 32 * 33 * 4 <= LDS_BYTES, "LDS map");

#define GAS __attribute__((address_space(1)))
#define LAS __attribute__((address_space(3)))
typedef unsigned short bf16;
typedef unsigned v4u __attribute__((ext_vector_type(4)));
typedef unsigned v2u __attribute__((ext_vector_type(2)));
typedef float f32x4 __attribute__((ext_vector_type(4)));
typedef float f32x2 __attribute__((ext_vector_type(2)));
typedef float f32x16 __attribute__((ext_vector_type(16)));
typedef short bf16x8 __attribute__((ext_vector_type(8)));
typedef GAS unsigned gu32;
#define RLX_AGENT __ATOMIC_RELAXED, __HIP_MEMORY_SCOPE_AGENT
__device__ __forceinline__ unsigned pk2(float lo, float hi) { typedef __bf16 b2 __attribute__((ext_vector_type(2))); f32x2 v = {lo, hi}; b2 b = __builtin_convertvector(v, b2); return __builtin_bit_cast(unsigned, b); }
__device__ __forceinline__ float bflo(unsigned u) { return __builtin_bit_cast(float, u << 16); }
__device__ __forceinline__ float bfhi(unsigned u) { return __builtin_bit_cast(float, u & 0xffff0000u); }
__device__ __forceinline__ float wave_sum(float v) {
#pragma unroll
    for (int o = 1; o < 64; o <<= 1) v += __shfl_xor(v, o);
    return v;
}

#define XB_TMO      128
#define XB_XCNT(j)  (256  + 64 * (j))
#define XB_XSUB(j)  (1280 + 64 * (j))
#define XB_XGEN(j)  (2304 + 64 * (j))
#define XB_TOP      3328
#define XB_TOPGEN   3392
#define XCD_BAR_WORDS 3456
#define XB_SPIN_CAP (1u << 18)

__device__ __forceinline__ unsigned xb_ld(unsigned* p)              { return __hip_atomic_load(p, __ATOMIC_RELAXED, __HIP_MEMORY_SCOPE_AGENT); }
__device__ __forceinline__ unsigned xb_add(unsigned* p, unsigned v) { return __hip_atomic_fetch_add(p, v, __ATOMIC_RELAXED, __HIP_MEMORY_SCOPE_AGENT); }
__device__ __forceinline__ unsigned xb_xcc_id() { return (unsigned)__builtin_amdgcn_s_getreg((3 << 11) | 20) & 0xFu; }
#define XB_SPIN(cond, bar) do { unsigned _sp = 0; while (cond) { __builtin_amdgcn_s_sleep(1); \
    if ((++_sp & 255u) == 0u) { if (xb_ld(&(bar)[XB_TMO])) break; if (_sp > XB_SPIN_CAP) { atomicAdd(&(bar)[XB_TMO], 1u); break; } } } } while (0)

struct XcdBarrier {
    unsigned* bar; unsigned x;
    volatile LAS unsigned* st;
};

__device__ __forceinline__ XcdBarrier xcd_barrier_post(unsigned* bar, volatile LAS unsigned* st) {
    XcdBarrier b; b.bar = bar; b.x = xb_xcc_id(); b.st = st;
    if (threadIdx.x == 0) (void)xb_add(&bar[XB_XCNT(b.x)], 1u);
    return b;
}
__device__ __forceinline__ void xcd_barrier_complete(unsigned* bar, unsigned x, unsigned& nloc, unsigned& nx) {
    const unsigned G = gridDim.x * gridDim.y * gridDim.z;
    unsigned sum, cnt, mine, sp = 0u;
    for (;;) {
        sum = 0u; cnt = 0u; mine = 0u;
#pragma unroll
        for (unsigned j = 0; j < 16; ++j) { const unsigned c = xb_ld(&bar[XB_XCNT(j)]); sum += c; cnt += (c > 0u) ? 1u : 0u; mine = (j == x) ? c : mine; }
        if (sum == G) break;
        __builtin_amdgcn_s_sleep(1);
        if ((++sp & 255u) == 0u) { if (xb_ld(&bar[XB_TMO])) break; if (sp > XB_SPIN_CAP) { atomicAdd(&bar[XB_TMO], 1u); break; } }
    }
    nloc = mine > 0u ? mine : 1u; nx = cnt > 0u ? cnt : 1u;
}

__device__ __forceinline__ void xcd_barrier(const XcdBarrier& b) {
    asm volatile("s_waitcnt vmcnt(0)" ::: "memory");
    __syncthreads();
    if (threadIdx.x == 0) {
        unsigned* bar = b.bar;
        __builtin_amdgcn_s_waitcnt(0);
        unsigned nloc = b.st[0], nx = b.st[1];
        if (nloc == 0u) { xcd_barrier_complete(bar, b.x, nloc, nx); b.st[0] = nloc; b.st[1] = nx; }
        const unsigned old = xb_add(&bar[XB_XSUB(b.x)], 1u);
        const unsigned gen = old / nloc;
        if (old + 1u == (gen + 1u) * nloc) {
            __builtin_amdgcn_fence(__ATOMIC_RELEASE, "agent");
            asm volatile("s_waitcnt vmcnt(0)" ::: "memory");
            const unsigned og = xb_add(&bar[XB_TOP], 1u);
            const unsigned tg = og / nx;
            if (og + 1u == (tg + 1u) * nx) xb_add(&bar[XB_TOPGEN], 1u);
            else XB_SPIN(xb_ld(&bar[XB_TOPGEN]) == tg, bar);
            __builtin_amdgcn_fence(__ATOMIC_ACQUIRE, "agent");
            xb_add(&bar[XB_XGEN(b.x)], 1u);
            asm volatile("s_waitcnt vmcnt(0)" ::: "memory");
        } else {
            XB_SPIN(xb_ld(&bar[XB_XGEN(b.x)]) == gen, bar);
            __builtin_amdgcn_fence(__ATOMIC_ACQUIRE, "agent");
            asm volatile("s_waitcnt vmcnt(0)" ::: "memory");
        }
    }
    __syncthreads();
}

namespace pg8 {
struct EpiInProjA {
    static constexpr bool PERM = true, AFTER_DRAIN = false, BIAS_DMA = false;
    unsigned char* ws; const float* qnw; const float* knw; const PG8_LAS float* ropeC;
    __device__ __forceinline__ void operator()(const f32x4 (&acc)[2][2][4][2], const Unit& u, int wr, int wc, int fr_in, int fq_in) const {
        int fr = fr_in, fq = fq_in; asm volatile("" : "+v"(fr), "+v"(fq));
        bf16_t* Qn = (bf16_t*)(ws + WS_QN); bf16_t* Kn = (bf16_t*)(ws + WS_KN); unsigned short* Vh = (unsigned short*)(ws + WS_VN); bf16_t* Pv = (bf16_t*)(ws + WS_P);
        const float* rope = (const float*)(ws + WS_ROPE); unsigned* vmax = (unsigned*)(ws + WS_CTL) + CW_VMAX;
        typedef _Float16 h2e __attribute__((ext_vector_type(2))); typedef float f2e __attribute__((ext_vector_type(2)));
        const int hg = 4 * u.pn + wc;
        const int row0 = u.pm * BM + wr * 64 + fr, sb = (u.pm * BM) & 16383;
        if (hg >= 30) {
            unsigned vm = 0u;
#pragma unroll
            for (int ai = 0; ai < 2; ++ai)
#pragma unroll
                for (int m = 0; m < 4; ++m) { const size_t row = (size_t)(row0 + ai * HALF + m * 16);
#pragma unroll
                    for (int bj = 0; bj < 2; ++bj) { const f32x4 v0 = acc[ai][bj][m][0], v1 = acc[ai][bj][m][1]; const int d = 32 * bj + 8 * fq;
                        u32x4 w; w.x = cvt_pk_bf16(v0[0], v0[1]); w.y = cvt_pk_bf16(v0[2], v0[3]); w.z = cvt_pk_bf16(v1[0], v1[1]); w.w = cvt_pk_bf16(v1[2], v1[3]);
                        *(u32x4*)(Pv + row * 2304 + hg * 64 + d) = w;
                        const unsigned ww[4] = {w.x, w.y, w.z, w.w};
#pragma unroll
                        for (int i = 0; i < 4; ++i) { const unsigned lo = ww[i] & 0x7fffu, hi = (ww[i] >> 16) & 0x7fffu; vm = vm > lo ? vm : lo; vm = vm > hi ? vm : hi; }
                        u32x4 h; { f2e t = {v0[0], v0[1]}; h.x = __builtin_bit_cast(unsigned, __builtin_convertvector(t, h2e)); } { f2e t = {v0[2], v0[3]}; h.y = __builtin_bit_cast(unsigned, __builtin_convertvector(t, h2e)); }
                        { f2e t = {v1[0], v1[1]}; h.z = __builtin_bit_cast(unsigned, __builtin_convertvector(t, h2e)); } { f2e t = {v1[2], v1[3]}; h.w = __builtin_bit_cast(unsigned, __builtin_convertvector(t, h2e)); }
                        *(u32x4*)(Vh + row * 384 + (hg - 30) * 64 + d) = h; } }
#pragma unroll
            for (int o = 1; o < 64; o <<= 1) { const unsigned t = (unsigned)__shfl_xor((int)vm, o); vm = vm > t ? vm : t; }
            if ((fr | fq) == 0) atomicMax(vmax, vm);
        } else {
            const bool isq = hg < 24; const float* nw = isq ? qnw : knw; const float sc = isq ? 0.125f * 1.4426950408889634f : 1.0f;
            const bool isx1 = fq < 2; const int i16b = 8 * (fq & 1);
            f32x4 wv[2][2];
#pragma unroll
            for (int bj = 0; bj < 2; ++bj)
#pragma unroll
                for (int n = 0; n < 2; ++n) wv[bj][n] = *(const f32x4*)(nw + 32 * bj + 8 * fq + 4 * n);
            bf16_t* obase = isq ? (Qn + hg * 64) : (Kn + (hg - 24) * 64); const int opitch = isq ? 1536 : 384;
#pragma unroll
            for (int ai = 0; ai < 2; ++ai) {
                const int pos_r = (sb + ai * HALF + wr * 64) >> 6;
                f32x4 er[4];
#pragma unroll
                for (int q = 0; q < 4; ++q) er[q] = *(const f32x4*)(rope + 2 * (pos_r * 16 + i16b) + 4 * q);
#pragma unroll
                for (int m = 0; m < 4; ++m) {
                    const int pos_c = 16 * m + fr; f32x4 ec[4];
#pragma unroll
                    for (int q = 0; q < 4; ++q) ec[q] = *(const PG8_LAS f32x4*)(ropeC + 2 * (pos_c * 16 + i16b) + 4 * q);
                    float ss = 0.f;
#pragma unroll
                    for (int bj = 0; bj < 2; ++bj)
#pragma unroll
                        for (int n = 0; n < 2; ++n) { const f32x4 x = acc[ai][bj][m][n]; ss += (x[0] * x[0] + x[1] * x[1]) + (x[2] * x[2] + x[3] * x[3]); }
                    { auto r16 = __builtin_amdgcn_permlane16_swap(__float_as_uint(ss), __float_as_uint(ss), false, false); ss = __uint_as_float(r16[0]) + __uint_as_float(r16[1]); }
                    { auto r32 = __builtin_amdgcn_permlane32_swap(__float_as_uint(ss), __float_as_uint(ss), false, false); ss = __uint_as_float(r32[0]) + __uint_as_float(r32[1]); }
                    const float rstd = __builtin_amdgcn_rsqf(ss * (1.f / 64.f) + 1e-6f);
                    const size_t row = (size_t)(row0 + ai * HALF + m * 16);
#pragma unroll
                    for (int bj = 0; bj < 2; ++bj) { float ov[8];
#pragma unroll
                        for (int n = 0; n < 2; ++n)
#pragma unroll
                            for (int j = 0; j < 4; ++j) { const int e = 4 * n + j; const f32x4 E = bj ? ec[e >> 1] : er[e >> 1];
                                const float c = (e & 1) ? E[2] : E[0], sn = (e & 1) ? E[3] : E[1];
                                const float y = acc[ai][bj][m][n][j] * rstd * wv[bj][n][j]; float py; { auto r32 = __builtin_amdgcn_permlane32_swap(__float_as_uint(y), __float_as_uint(y), false, false); py = __uint_as_float(fq < 2 ? r32[1] : r32[0]); }
                                ov[e] = (isx1 ? (y * c - py * sn) : (y * c + py * sn)) * sc; }
                        u32x4 w; w.x = cvt_pk_bf16(ov[0], ov[1]); w.y = cvt_pk_bf16(ov[2], ov[3]); w.z = cvt_pk_bf16(ov[4], ov[5]); w.w = cvt_pk_bf16(ov[6], ov[7]);
                        *(u32x4*)(obase + row * opitch + 32 * bj + 8 * fq) = w; }
                }
            }
        }
    }
};
}

template <int REMAP>
__device__ __forceinline__ void transpose_item(const float* __restrict__ W, int N, bf16* __restrict__ WT, int k0, int n0, int lane) {
    const int n = n0 + 4 * lane;
    int drow = n;
    if (REMAP == 1) { const int isup = n >= 2048; const int s = isup ? n - 2048 : n; drow = 256 * (s >> 7) + (isup ? 128 : 0) + (s & 127); }
    if (REMAP == 2) { const int c = n & 255; drow = (n & ~255) + 128 * ((c & 63) >> 5) + 32 * (c >> 6) + (c & 31); }
#pragma unroll 2
    for (int kc = 0; kc < 8; ++kc) {
        const int k = k0 + 8 * kc;
        f32x4 v[8];
#pragma unroll
        for (int i = 0; i < 8; ++i) v[i] = __builtin_nontemporal_load((const f32x4*)(W + (size_t)(k + i) * N + n));
        __builtin_amdgcn_sched_barrier(0);
#pragma unroll
        for (int j = 0; j < 4; ++j) { v4u o; o.x = pk2(v[0][j], v[1][j]); o.y = pk2(v[2][j], v[3][j]); o.z = pk2(v[4][j], v[5][j]); o.w = pk2(v[6][j], v[7][j]);
            *(v4u*)(WT + (size_t)(drow + j) * 2048 + k) = o; }
    }
}
template <int REMAP>
__device__ __forceinline__ void transpose_item_f8(const float* __restrict__ W, int N, unsigned char* __restrict__ WT, int k0, int n0, int lane, float sc) {
    const int n = n0 + 4 * lane;
    int drow = n;
    if (REMAP == 1) { const int isup = n >= 2048; const int s = isup ? n - 2048 : n; drow = 256 * (s >> 7) + (isup ? 128 : 0) + (s & 127); }
#pragma unroll 1
    for (int kc = 0; kc < 4; ++kc) {
        const int k = k0 + 16 * kc;
        f32x4 v[16];
#pragma unroll
        for (int i = 0; i < 16; ++i) v[i] = __builtin_nontemporal_load((const f32x4*)(W + (size_t)(k + i) * N + n));
        __builtin_amdgcn_sched_barrier(0);
#pragma unroll
        for (int i = 0; i < 16; ++i) v[i] = v[i] * sc;
#pragma unroll
        for (int j = 0; j < 4; ++j) { v4u o; o.x = pg8::pk4_fp8(v[0][j], v[1][j], v[2][j], v[3][j]); o.y = pg8::pk4_fp8(v[4][j], v[5][j], v[6][j], v[7][j]);
            o.z = pg8::pk4_fp8(v[8][j], v[9][j], v[10][j], v[11][j]); o.w = pg8::pk4_fp8(v[12][j], v[13][j], v[14][j], v[15][j]);
            *(v4u*)(WT + (size_t)(drow + j) * 2048 + k) = o; }
    }
}
__device__ __forceinline__ void rms_row_to_bf16(const float* __restrict__ xrow, const f32x4 (&wv)[8], bf16* __restrict__ orow, unsigned char* __restrict__ orow8, int lane) {
    const f32x4* xr = (const f32x4*)xrow + lane;
    f32x4 v[8]; float ss = 0.f;
#pragma unroll
    for (int j = 0; j < 8; ++j) v[j] = xr[64 * j];
    __builtin_amdgcn_sched_barrier(0);
#pragma unroll
    for (int j = 0; j < 8; ++j) ss += (v[j].x * v[j].x + v[j].y * v[j].y) + (v[j].z * v[j].z + v[j].w * v[j].w);
    const float rstd = rsqrtf(wave_sum(ss) * (1.f / 2048.f) + NORM_EPS);
    v2u* o8 = (v2u*)orow + lane;
#pragma unroll
    for (int j = 0; j < 8; ++j) { const f32x4 ww = wv[j]; const float h0 = v[j].x * rstd * ww.x, h1 = v[j].y * rstd * ww.y, h2 = v[j].z * rstd * ww.z, h3 = v[j].w * rstd * ww.w;
        v2u o; o.x = pk2(h0, h1); o.y = pk2(h2, h3); o8[64 * j] = o; ((unsigned*)orow8)[lane + 64 * j] = pg8::pk4_fp8(h0, h1, h2, h3); }
}
__device__ __forceinline__ void moe_weight_convert_blk(const float* __restrict__ w_gate_up, const float* __restrict__ w_down, unsigned char* __restrict__ Wgu8, unsigned char* __restrict__ Wd8,
                                                       unsigned char* ldsb, int blk, int nblk, int wave, int lane, float sc) {
    constexpr int I_GU = 8 * 16, I_D = 8 * 8, NIT = NE * (I_GU + I_D);
    asm volatile("" : "+v"(lane));
    f32x4 v[32];
#define MWC_DECODE(it_, src_, N_, dst_, k0_, n0_, gu_) do { if ((it_) < NE * I_GU) { const int e_ = (it_) / I_GU, q_ = (it_) % I_GU; src_ = w_gate_up + (size_t)e_ * 2048 * 4096; N_ = 4096; dst_ = Wgu8 + (size_t)e_ * 4096 * 2048; k0_ = 256 * (q_ / 16); n0_ = 256 * (q_ % 16); gu_ = 1; } \
        else { const int r_ = (it_) - NE * I_GU, e_ = r_ / I_D, q_ = r_ % I_D; src_ = w_down + (size_t)e_ * 2048 * 2048; N_ = 2048; dst_ = Wd8 + (size_t)e_ * 2048 * 2048; k0_ = 256 * (q_ / 8); n0_ = 256 * (q_ % 8); gu_ = 0; } } while (0)
#define MWC_LOAD(src_, N_, k0_, n0_) do { const float* p_ = (src_) + (size_t)((k0_) + 32 * wave) * (N_) + (n0_) + 4 * lane; _Pragma("unroll") for (int r_ = 0; r_ < 32; ++r_) v[r_] = __builtin_nontemporal_load((const f32x4*)(p_ + (size_t)r_ * (N_))); } while (0)
    int it = blk, buf = 0;
    const float* src = w_gate_up; unsigned char* dst = Wgu8; int N = 4096, k0 = 0, n0 = 0, gu = 1;
    if (it < NIT) { MWC_DECODE(it, src, N, dst, k0, n0, gu); MWC_LOAD(src, N, k0, n0); }
    for (; it < NIT; it += nblk) {
        __builtin_amdgcn_sched_barrier(0);
        unsigned char* img = ldsb + buf * 65536;
#pragma unroll
        for (int j = 0; j < 4; ++j) {
#pragma unroll
            for (int hh = 0; hh < 2; ++hh) { v4u o; o.x = pg8::pk4_fp8(v[16 * hh + 0][j] * sc, v[16 * hh + 1][j] * sc, v[16 * hh + 2][j] * sc, v[16 * hh + 3][j] * sc); o.y = pg8::pk4_fp8(v[16 * hh + 4][j] * sc, v[16 * hh + 5][j] * sc, v[16 * hh + 6][j] * sc, v[16 * hh + 7][j] * sc);
                o.z = pg8::pk4_fp8(v[16 * hh + 8][j] * sc, v[16 * hh + 9][j] * sc, v[16 * hh + 10][j] * sc, v[16 * hh + 11][j] * sc); o.w = pg8::pk4_fp8(v[16 * hh + 12][j] * sc, v[16 * hh + 13][j] * sc, v[16 * hh + 14][j] * sc, v[16 * hh + 15][j] * sc);
                *(v4u*)(img + (4 * lane + j) * 256 + 16 * ((2 * wave + hh) ^ (lane & 7))) = o; } }
        asm volatile("s_waitcnt lgkmcnt(0)" ::: "memory"); __builtin_amdgcn_s_barrier();
        __builtin_amdgcn_sched_barrier(0);
        const int nxt = it + nblk; const unsigned char* cdst = dst; const int ck0 = k0, cn0 = n0, cgu = gu;
        if (nxt < NIT) { MWC_DECODE(nxt, src, N, dst, k0, n0, gu); MWC_LOAD(src, N, k0, n0); }
        __builtin_amdgcn_sched_barrier(0);
#pragma unroll
        for (int qq = 0; qq < 2; ++qq) {
            v4u dd[4];
#pragma unroll
            for (int q = 0; q < 4; ++q) { const int n = 32 * wave + 16 * qq + 4 * q + (lane >> 4), c = lane & 15; dd[q] = *(const v4u*)(img + n * 256 + 16 * (c ^ ((n >> 2) & 7))); }
            __builtin_amdgcn_sched_barrier(0);
#pragma unroll
            for (int q = 0; q < 4; ++q) { const int n = 32 * wave + 16 * qq + 4 * q + (lane >> 4), c = lane & 15;
                const int ng = cn0 + n; int drow = ng;
                if (cgu) { const int isup = cn0 >= 2048; const int s = isup ? ng - 2048 : ng; drow = 256 * (s >> 7) + (isup ? 128 : 0) + (s & 127); }
                *(v4u*)((unsigned char*)cdst + (size_t)drow * 2048 + ck0 + 16 * c) = dd[q]; }
        }
        buf ^= 1;
    }
    asm volatile("s_waitcnt vmcnt(0) lgkmcnt(0)" ::: "memory"); __builtin_amdgcn_s_barrier();
#undef MWC_DECODE
#undef MWC_LOAD
}
__device__ __forceinline__ v4u bf8_to_h8(v4u r) {
    typedef _Float16 h2v __attribute__((ext_vector_type(2)));
    v4u o;
    { f32x2 t = {bflo(r.x), bfhi(r.x)}; o.x = __builtin_bit_cast(unsigned, __builtin_convertvector(t, h2v)); }
    { f32x2 t = {bflo(r.y), bfhi(r.y)}; o.y = __builtin_bit_cast(unsigned, __builtin_convertvector(t, h2v)); }
    { f32x2 t = {bflo(r.z), bfhi(r.z)}; o.z = __builtin_bit_cast(unsigned, __builtin_convertvector(t, h2v)); }
    { f32x2 t = {bflo(r.w), bfhi(r.w)}; o.w = __builtin_bit_cast(unsigned, __builtin_convertvector(t, h2v)); }
    return o;
}
__device__ __forceinline__ unsigned umax4(unsigned m, v4u r) {
    const unsigned w[4] = {r.x, r.y, r.z, r.w};
#pragma unroll
    for (int i = 0; i < 4; ++i) { const unsigned lo = w[i] & 0x7fffu, hi = (w[i] >> 16) & 0x7fffu; m = m > lo ? m : lo; m = m > hi ? m : hi; }
    return m;
}
__device__ __forceinline__ void moe_tables(unsigned* gcnt, int* tile_e, int* ppad, int* ecnt, int tid) {
    __syncthreads();
    if (tid == 0) { int acc = 0;
        for (int e = 0; e < NE; ++e) { const int c = (int)__hip_atomic_load(gcnt + e, RLX_AGENT); const int nt = (c + 255) >> 8; ppad[e] = acc * 256; ecnt[e] = c; for (int t = 0; t < nt; ++t) tile_e[acc + t] = e; acc += nt; }
        ppad[32] = acc * 256; ppad[33] = acc; }
    __syncthreads();
}

struct Args { const float* in[15]; float* out; unsigned char* ws; int ph_lo, ph_hi; };
__global__ void __launch_bounds__(NWAVES * 64, 2) mk_fwd(Args args) {
    extern __shared__ __attribute__((aligned(16))) unsigned char lds[];
    const int tid = threadIdx.x, lane = tid & 63, wave = __builtin_amdgcn_readfirstlane(tid >> 6);
    const int G = gridDim.x, bx = blockIdx.x;
    const int nx = (G % 8 == 0) ? 8 : 1, gx = G / nx;
    const int vcu = (bx % nx) * gx + bx / nx;
    const int gw = vcu * NWAVES + wave, NGW = G * NWAVES;
    unsigned char* ws = args.ws;
    unsigned* ctl = (unsigned*)(ws + WS_CTL);
    const float* x = args.in[0]; const float* norm_mix_w = args.in[1]; const float* w_in = args.in[2]; const float* q_norm_w = args.in[3]; const float* k_norm_w = args.in[4];
    const float* out_norm_w = args.in[5]; const float* w_out = args.in[6]; const float* norm_moe_w = args.in[7]; const float* w_router = args.in[8]; const float* b_router = args.in[9];
    const float* w_gate_up = args.in[10]; const float* b_gate_up = args.in[11]; const float* w_down = args.in[12]; const float* b_down = args.in[13]; const float* final_norm_w = args.in[14];
    float* out = args.out;
    f32x2* rope = (f32x2*)(ws + WS_ROPE);
    bf16* WrT = (bf16*)(ws + WS_WRT); bf16* WinT = (bf16*)(ws + WS_WIN); bf16* WoutT = (bf16*)(ws + WS_WOUT); unsigned char* Wgu8 = ws + WS_WGU; unsigned char* Wd8 = ws + WS_WD;
    bf16* Hn = (bf16*)(ws + WS_HN); bf16* P = (bf16*)(ws + WS_P); bf16* PB = (bf16*)(ws + WS_P + 144 * MiB); bf16* Qn = (bf16*)(ws + WS_QN); bf16* Kn = (bf16*)(ws + WS_KN); bf16* Vn = (bf16*)(ws + WS_VN); bf16* Oa = (bf16*)(ws + WS_OA);
    bf16* Ob = (bf16*)(ws + WS_OB); float* Lse = (float*)(ws + WS_LSE); bf16* Mg = (bf16*)(ws + WS_MG); bf16* X1 = (bf16*)(ws + WS_X1);
    int* Eidx = (int*)(ws + WS_EIDX); int* Rank = (int*)(ws + WS_RANK); float* Gate = (float*)(ws + WS_GATE);
    unsigned char* Y8 = ws + WS_XG; unsigned char* Hact8 = ws + WS_H + 272 * MiB; unsigned char* Hnx8 = ws + WS_H;
    unsigned char* Win8 = ws + WS_WIN + 9 * MiB;                    unsigned char* Hn8 = ws + WS_HN;
    constexpr float WSC = 32.0f, WSC_INV = 1.0f / 32.0f;
    unsigned* gcnt = ctl + CW_CNT;
    int* tile_e = (int*)(lds + TBL_OFF); int* ppad = (int*)(lds + PP_OFF); int* ecnt = (int*)(lds + CNT_OFF); int* tokbuf = (int*)(lds + ROUTE_OFF);
    int* TokOf = (int*)(ws + WS_TOKOF);

    for (int u = tid; u < (LDS_BYTES - LDSCTL_OFF) / 4; u += NWAVES * 64) ((unsigned*)(lds + LDSCTL_OFF))[u] = 0u;
    __syncthreads();
#if MK_SPLIT
#define GRID_BAR() do { } while (0)
#define GRID_BAR_F() (void)0
#else
    XcdBarrier bar = xcd_barrier_post(ctl + CW_BAR, (volatile LAS unsigned*)(lds + MISC_OFF) + 8);
#define GRID_BAR() xcd_barrier(bar)
#define GRID_BAR_F() xcd_barrier(bar)
#endif
    const int lo = args.ph_lo, hi_ph = args.ph_hi;
#define IN(k) (lo <= (k) && (k) < hi_ph)
#ifndef PROBE_MASK
#define PROBE_MASK 0
#endif
#define PHASE_REP(k) _Pragma("unroll") for (int rep_ = 0; rep_ <= ((PROBE_MASK >> (k)) & 1); ++rep_) if (rep_ > 0 && (GRID_BAR_F(), false)) {} else
#define PHASE_LANE() int lane_l_ = (int)__builtin_amdgcn_mbcnt_hi(~0u, __builtin_amdgcn_mbcnt_lo(~0u, 0u)); asm volatile("" : "+v"(lane_l_)); const int lane = lane_l_, tid = wave * 64 + lane_l_; (void)tid
#define BOTH(k) (IN(k) && IN((k) + 1))

    if (IN(0)) { PHASE_REP(0) {
        PHASE_LANE();
        constexpr int I_IN = 32 * 27, I_OUT = 32 * 8;
        constexpr int NITEMS = I_IN + I_OUT;
        for (int it = gw; it < NITEMS; it += NGW) {
            int r = it;
            if (r < I_IN) { const int nb = r % 27; if (nb < 9) transpose_item<2>(w_in, INW, WinT, 64 * (r / 27), 256 * nb, lane); else transpose_item_f8<0>(w_in, INW, Win8 - (size_t)2304 * 2048, 64 * (r / 27), 256 * nb, lane, WSC); continue; } r -= I_IN;
            transpose_item<0>(w_out, DM, WoutT, 64 * (r / 8), 256 * (r % 8), lane);
        }
        const int gt = gw * 64 + lane;
        if (gt < 8192) { const int n = gt & 31, kc = gt >> 5; float v[8];
#pragma unroll
            for (int i = 0; i < 8; ++i) v[i] = w_router[(size_t)(8 * kc + i) * NE + n];
            v4u o; o.x = pk2(v[0], v[1]); o.y = pk2(v[2], v[3]); o.z = pk2(v[4], v[5]); o.w = pk2(v[6], v[7]);
            *(v4u*)(WrT + (size_t)n * 2048 + 8 * kc) = o; }
        if (gt >= 8192 && gt < 8192 + 4096) { const int id = gt - 8192, pos = id >> 4, i = id & 15;
            double th = 1.0; for (int q = 0; q < i; ++q) th *= 0.56234132519034908;
            double c = 1.0, s = th, tc = 1.0, tsn = th; const double t2 = th * th;
            for (int n = 1; n <= 11; ++n) { tc *= -t2 / (double)((2 * n - 1) * (2 * n)); c += tc; tsn *= -t2 / (double)((2 * n) * (2 * n + 1)); s += tsn; }
            double rc = 1.0, rs = 0.0, bc = c, bs = s;
            for (int bit = 0; bit < 9; ++bit) { if ((pos >> bit) & 1) { const double t = rc * bc - rs * bs; rs = rc * bs + rs * bc; rc = t; } const double t = bc * bc - bs * bs; bs = 2.0 * bc * bs; bc = t; }
            f32x2 cs; cs.x = (float)rc; cs.y = (float)rs; rope[id] = cs; }
        { f32x4 wv[8];
#pragma unroll
          for (int j = 0; j < 8; ++j) wv[j] = ((const f32x4*)norm_mix_w)[lane + 64 * j];
          for (int m = gw; m < MTOK; m += NGW) rms_row_to_bf16(x + (size_t)m * DM, wv, Hn + (size_t)m * DM, Hnx8 + (size_t)m * DM, lane); }
        }
        if (BOTH(0)) GRID_BAR();
    }

    if (IN(1)) { PHASE_REP(1) {
        PHASE_LANE();
        {
            float* ropeC = (float*)(lds + ROUTE_OFF);
            for (int i = tid; i < 2048; i += NWAVES * 64) ropeC[i] = ((const float*)rope)[i];
            __syncthreads();
            pg8::StaticOrder S; S.init(MTOK / 256, 9, G, bx);
            pg8::EpiInProjA E{ws, q_norm_w, k_norm_w, (const PG8_LAS float*)ropeC};
            pg8::gemm_phase<pg8::EpiInProjA, pg8::StaticOrder, true, true>((PG8_LAS unsigned char*)lds + RING_OFF, DM, (const char*)Hn, (const char*)WinT, S, E);
        }
        {
            pg8::BalancedOrder S; S.init(MTOK / 256, 18, G, bx, ((MTOK / 256) * 9) % G, 2, 1);
            pg8::EpiInProj E{P, PB, 9, WSC_INV};
            pg8::gemm_phase<pg8::EpiInProj, pg8::BalancedOrder, true, true, true>((PG8_LAS unsigned char*)lds + RING_OFF, DM / 2, (const char*)Hnx8, (const char*)Win8, S, E);
        }
        }
        if (BOTH(1)) GRID_BAR();
    }


    if (IN(3)) { PHASE_REP(3) {
        PHASE_LANE();
        bool conv_done = false;
        {
            const int per = 3072 / nx, xcd = vcu / gx, vi = vcu % gx;
            float mq = 0.f, mk = 0.f;
            for (int i = 0; i < 64; ++i) { mq = fmaxf(mq, fabsf(q_norm_w[i])); mk = fmaxf(mk, fabsf(k_norm_w[i])); }
            const float b2 = 8.0f * 1.4426950408889634f * mq * mk;
            const float vmaxf = __uint_as_float(__hip_atomic_load(ctl + CW_VMAX, RLX_AGENT) << 16);
            const bool fixed_ref = b2 <= 14.0f && vmaxf < 6.0e4f;
            const float mref = fmaxf(b2 - 9.0f, 0.0f);
            const int rounds = (per + gx - 1) / gx, cslot = vcu % rounds; int ri = 0;
            for (int li = vi; li < per; li += gx, ++ri) {
                if (ri == cslot) { moe_weight_convert_blk(w_gate_up, w_down, Wgu8, Wd8, lds + RING_OFF, vcu, G, wave, lane, WSC); conv_done = true; }
                const int u = xcd * per + li;
                const int qb = u & 63, g4 = (u >> 6) & 3, kvh = (u >> 8) % 6, b = u / 1536, qh = kvh * 4 + g4;
                const size_t qoff = ((size_t)b * SEQ + (size_t)qb * 256) * AQW + qh * 64;
                const attn_body::bf16* kp = (const attn_body::bf16*)Kn + (size_t)b * SEQ * AKVW + kvh * 64; const attn_body::bf16* vp = (const attn_body::bf16*)Vn + (size_t)b * SEQ * AKVW + kvh * 64; const attn_body::bf16* vraw = (const attn_body::bf16*)P + (size_t)b * SEQ * 2304 + (AQW + AKVW) + kvh * 64;
                if (fixed_ref) attn_body::attn_unit<true, 8, AQW, AKVW, AKVW, AQW, SEQ / 64>((const attn_body::bf16*)Qn + qoff, kp, vp, (attn_body::bf16*)Oa + qoff, (char*)lds + RING_OFF, mref);
                else attn_body::attn_unit<false, 8, AQW, AKVW, 2304, AQW, SEQ / 64>((const attn_body::bf16*)Qn + qoff, kp, vraw, (attn_body::bf16*)Oa + qoff, (char*)lds + RING_OFF, 0.f);
            }
        }
        if (!conv_done) moe_weight_convert_blk(w_gate_up, w_down, Wgu8, Wd8, lds + RING_OFF, vcu, G, wave, lane, WSC);
        {
            attn_body::attnb_phase(vcu, G, (const attn_body::bf16*)PB, (attn_body::bf16*)Ob, Lse, (char*)lds + RING_OFF, ctl + CW_QB);
        }
        }
        if (BOTH(3)) GRID_BAR();
    }

    if (IN(4)) { PHASE_REP(4) {
        PHASE_LANE();
        f32x4 onw[8];
#pragma unroll
        for (int j = 0; j < 3; ++j) { onw[2 * j] = *(const f32x4*)(out_norm_w + 8 * (lane + 64 * j)); onw[2 * j + 1] = *(const f32x4*)(out_norm_w + 8 * (lane + 64 * j) + 4); }
        onw[6] = *(const f32x4*)(out_norm_w + AQW + 8 * lane); onw[7] = *(const f32x4*)(out_norm_w + AQW + 8 * lane + 4);
        for (int row = gw; row < MTOK; row += NGW) {
            float oa[24]; float ssa = 0.f;
#pragma unroll
            for (int j = 0; j < 3; ++j) { const v4u raw = *(const v4u*)(Oa + (size_t)row * AQW + 8 * (lane + 64 * j));
                oa[8 * j + 0] = bflo(raw.x); oa[8 * j + 1] = bfhi(raw.x); oa[8 * j + 2] = bflo(raw.y); oa[8 * j + 3] = bfhi(raw.y); oa[8 * j + 4] = bflo(raw.z); oa[8 * j + 5] = bfhi(raw.z); oa[8 * j + 6] = bflo(raw.w); oa[8 * j + 7] = bfhi(raw.w); }
#pragma unroll
            for (int i = 0; i < 24; ++i) ssa += oa[i] * oa[i];
            const float rsa = rsqrtf(wave_sum(ssa) * (1.f / 1536.f) + NORM_EPS);
            const int h = lane >> 3;
            const float l0 = Lse[((size_t)0 * MTOK + row) * 8 + h], l1 = Lse[((size_t)1 * MTOK + row) * 8 + h], l2 = Lse[((size_t)2 * MTOK + row) * 8 + h];
            const float lm = fmaxf(l0, fmaxf(l1, l2));
            float w0 = __builtin_amdgcn_exp2f(l0 - lm), w1 = __builtin_amdgcn_exp2f(l1 - lm), w2 = __builtin_amdgcn_exp2f(l2 - lm);
            const float wi = 1.0f / (w0 + w1 + w2); w0 *= wi; w1 *= wi; w2 *= wi;
            const v4u r0 = *(const v4u*)(Ob + ((size_t)0 * MTOK + row) * BW + 8 * lane), r1 = *(const v4u*)(Ob + ((size_t)1 * MTOK + row) * BW + 8 * lane), r2 = *(const v4u*)(Ob + ((size_t)2 * MTOK + row) * BW + 8 * lane);
            float ob[8];
            ob[0] = w0 * bflo(r0.x) + w1 * bflo(r1.x) + w2 * bflo(r2.x); ob[1] = w0 * bfhi(r0.x) + w1 * bfhi(r1.x) + w2 * bfhi(r2.x);
            ob[2] = w0 * bflo(r0.y) + w1 * bflo(r1.y) + w2 * bflo(r2.y); ob[3] = w0 * bfhi(r0.y) + w1 * bfhi(r1.y) + w2 * bfhi(r2.y);
            ob[4] = w0 * bflo(r0.z) + w1 * bflo(r1.z) + w2 * bflo(r2.z); ob[5] = w0 * bfhi(r0.z) + w1 * bfhi(r1.z) + w2 * bfhi(r2.z);
            ob[6] = w0 * bflo(r0.w) + w1 * bflo(r1.w) + w2 * bflo(r2.w); ob[7] = w0 * bfhi(r0.w) + w1 * bfhi(r1.w) + w2 * bfhi(r2.w);
            float ssb = 0.f;
#pragma unroll
            for (int i = 0; i < 8; ++i) ssb += ob[i] * ob[i];
            const float rsb = rsqrtf(wave_sum(ssb) * (1.f / 512.f) + NORM_EPS);
            bf16* mrow = Mg + (size_t)row * DM;
#pragma unroll
            for (int j = 0; j < 3; ++j) { const int c = 8 * (lane + 64 * j); const f32x4 wa = onw[2 * j], wb = onw[2 * j + 1];
                v4u o; o.x = pk2(oa[8 * j + 0] * rsa * wa.x, oa[8 * j + 1] * rsa * wa.y); o.y = pk2(oa[8 * j + 2] * rsa * wa.z, oa[8 * j + 3] * rsa * wa.w);
                o.z = pk2(oa[8 * j + 4] * rsa * wb.x, oa[8 * j + 5] * rsa * wb.y); o.w = pk2(oa[8 * j + 6] * rsa * wb.z, oa[8 * j + 7] * rsa * wb.w); *(v4u*)(mrow + c) = o; }
            { const int c = AQW + 8 * lane; const f32x4 wa = onw[6], wb = onw[7];
                v4u o; o.x = pk2(ob[0] * rsb * wa.x, ob[1] * rsb * wa.y); o.y = pk2(ob[2] * rsb * wa.z, ob[3] * rsb * wa.w); o.z = pk2(ob[4] * rsb * wb.x, ob[5] * rsb * wb.y); o.w = pk2(ob[6] * rsb * wb.z, ob[7] * rsb * wb.w); *(v4u*)(mrow + c) = o; }
        }
        }
        if (BOTH(4)) GRID_BAR();
    }

    if (IN(5)) { PHASE_REP(5) {
        PHASE_LANE();
        pg8::StaticOrder S; S.init(MTOK / 256, DM / 256, G, bx);
        pg8::EpiResidBf16 E{x, X1, DM};
        pg8::gemm_phase<pg8::EpiResidBf16, pg8::StaticOrder, true, true>((PG8_LAS unsigned char*)lds + RING_OFF, DM, (const char*)Mg, (const char*)WoutT, S, E);
        }
        if (BOTH(5)) GRID_BAR();
    }

    if (IN(6)) { PHASE_REP(6) {
        PHASE_LANE();
        int* lcnt = (int*)(lds + CNT_OFF); int* lbase = lcnt + 32; int* le = (int*)(lds + ROUTE_OFF); int* lrank = le + 512;
        float* logit = (float*)(lds + LOGIT_OFF); unsigned char* tile = lds + RING_OFF; float* part = (float*)(lds + RING_OFF);
        const int r32 = lane & 31, hi = lane >> 5;
        f32x4 wmo[8];
#pragma unroll
        for (int j = 0; j < 4; ++j) { wmo[2 * j] = *(const f32x4*)(norm_moe_w + 8 * (lane + 64 * j)); wmo[2 * j + 1] = *(const f32x4*)(norm_moe_w + 8 * (lane + 64 * j) + 4); }
        for (int chunk = bx; chunk < MTOK / 128; chunk += G) {
            if (tid < 32) lcnt[tid] = 0;
            __syncthreads();
#pragma unroll 1
            for (int grp = 0; grp < 4; ++grp) {
                const int row0 = chunk * 128 + grp * 32;
                v4u xr_[4][4];
#pragma unroll
                for (int rr = 0; rr < 4; ++rr)
#pragma unroll
                    for (int j = 0; j < 4; ++j) xr_[rr][j] = ((const v4u*)(X1 + ((size_t)row0 + 4 * wave + rr) * DM))[lane + 64 * j];
                __builtin_amdgcn_sched_barrier(0);
#pragma unroll
                for (int rr = 0; rr < 4; ++rr) {
                    const int r = 4 * wave + rr; const size_t grow = (size_t)row0 + r;
                    float xv[4][8]; float ss = 0.f;
#pragma unroll
                    for (int j = 0; j < 4; ++j) { const v4u q = xr_[rr][j]; xv[j][0] = bflo(q.x); xv[j][1] = bfhi(q.x); xv[j][2] = bflo(q.y); xv[j][3] = bfhi(q.y); xv[j][4] = bflo(q.z); xv[j][5] = bfhi(q.z); xv[j][6] = bflo(q.w); xv[j][7] = bfhi(q.w);
#pragma unroll
                        for (int i = 0; i < 8; ++i) ss += xv[j][i] * xv[j][i]; }
                    const float rstd = rsqrtf(wave_sum(ss) * (1.f / 2048.f) + NORM_EPS);
#pragma unroll
                    for (int j = 0; j < 4; ++j) { const f32x4 wa = wmo[2 * j], wb = wmo[2 * j + 1];
                        const float h0 = xv[j][0] * rstd * wa.x, h1 = xv[j][1] * rstd * wa.y, h2 = xv[j][2] * rstd * wa.z, h3 = xv[j][3] * rstd * wa.w;
                        const float h4 = xv[j][4] * rstd * wb.x, h5 = xv[j][5] * rstd * wb.y, h6 = xv[j][6] * rstd * wb.z, h7 = xv[j][7] * rstd * wb.w;
                        v4u o; o.x = pk2(h0, h1); o.y = pk2(h2, h3); o.z = pk2(h4, h5); o.w = pk2(h6, h7);
                        v2u o8; o8.x = pg8::pk4_fp8(h0, h1, h2, h3); o8.y = pg8::pk4_fp8(h4, h5, h6, h7);
                        ((v2u*)(Hn8 + grow * DM))[lane + 64 * j] = o8;
                        *(v4u*)(tile + (lane + 64 * j) * 512 + r * 16) = o; }
                }
                __syncthreads();
                f32x16 acc = f32x16{};
#pragma unroll 4
                for (int s = 0; s < 16; ++s) { const int kk = 16 * wave + s;
                    const bf16x8 a = *(const bf16x8*)(tile + ((kk * 2 + hi) * 32 + r32) * 16);
                    const bf16x8 b = *(const bf16x8*)(WrT + (size_t)r32 * 2048 + 16 * kk + 8 * hi);
                    acc = __builtin_amdgcn_mfma_f32_32x32x16_bf16(a, b, acc, 0, 0, 0); }
                __syncthreads();
#pragma unroll
                for (int r = 0; r < 16; ++r) part[(wave * 32 + ((r & 3) + 8 * (r >> 2) + 4 * hi)) * 33 + r32] = acc[r];
                __syncthreads();
#pragma unroll
                for (int q = 0; q < 2; ++q) { const int idx = tid * 2 + q, row = idx >> 5, e = idx & 31; float sm = 0.f;
#pragma unroll
                    for (int w = 0; w < 8; ++w) sm += part[(w * 32 + row) * 33 + e];
                    logit[row * 33 + e] = sm + b_router[e]; }
                __syncthreads();
                if (tid < 32) { const int row = tid; unsigned taken = 0u; float tv[4]; int te[4];
#pragma unroll
                    for (int k = 0; k < 4; ++k) { float best = -INFINITY; int bi = 0;
                        for (int e = 0; e < 32; ++e) { const float v = logit[row * 33 + e]; const bool ok = !((taken >> e) & 1u) && (v > best); best = ok ? v : best; bi = ok ? e : bi; }
                        taken |= 1u << bi; tv[k] = best; te[k] = bi; }
                    float ex[4], sum = 0.f;
#pragma unroll
                    for (int k = 0; k < 4; ++k) { ex[k] = __builtin_amdgcn_exp2f((tv[k] - tv[0]) * 1.4426950408889634f); sum += ex[k]; }
                    const float inv = 1.0f / sum; const size_t grow = (size_t)row0 + row;
                    f32x4 gv = {ex[0] * inv, ex[1] * inv, ex[2] * inv, ex[3] * inv}; *(f32x4*)(Gate + grow * 4) = gv;
#pragma unroll
                    for (int k = 0; k < 4; ++k) { const int lr = __hip_atomic_fetch_add(lcnt + te[k], 1, __ATOMIC_RELAXED, __HIP_MEMORY_SCOPE_WORKGROUP); le[(grp * 32 + row) * 4 + k] = te[k]; lrank[(grp * 32 + row) * 4 + k] = lr; }
                }
                __syncthreads();
            }
            if (tid < 32) lbase[tid] = (int)__hip_atomic_fetch_add(gcnt + tid, (unsigned)lcnt[tid], RLX_AGENT);
            __syncthreads();
            { const size_t gi = (size_t)chunk * 512 + tid; const int e = le[tid]; const int rk = lbase[e] + lrank[tid]; Eidx[gi] = e; Rank[gi] = rk; TokOf[(size_t)e * 32768 + rk] = (int)(gi >> 2); }
            __syncthreads();
        }
        }
        if (BOTH(6)) GRID_BAR();
    }


    if (IN(8)) { PHASE_REP(8) {
        PHASE_LANE();
        moe_tables(gcnt, tile_e, ppad, ecnt, tid);
        pg8::MoeGatherOrder S; S.so.init(__builtin_amdgcn_readfirstlane(ppad[33]), 16, G, bx); S.tile_e = (const PG8_LAS int*)tile_e; S.ppad = (const PG8_LAS int*)ppad; S.ecnt = (const PG8_LAS int*)ecnt;
        S.tokof = TokOf; S.tokbuf = (PG8_LAS int*)tokbuf; S.dt.init(ctl + CW_Q8, (PG8_LAS int*)(lds + QW_OFF), S.so.nwg, G);
        pg8::EpiSwiglu E{Hact8, b_gate_up, WSC_INV, (PG8_LAS float*)(lds + LOGIT_OFF)};
        pg8::gemm_phase<pg8::EpiSwiglu, pg8::MoeGatherOrder, true, true, true, true>((PG8_LAS unsigned char*)lds + RING_OFF, DM / 2, (const char*)Hn8, (const char*)Wgu8, S, E);
        }
        if (BOTH(8)) GRID_BAR();
    }

    if (IN(9)) { PHASE_REP(9) {
        PHASE_LANE();
        moe_tables(gcnt, tile_e, ppad, ecnt, tid);
        pg8::MoeOrder S; S.so.init(__builtin_amdgcn_readfirstlane(ppad[33]), 8, G, bx); S.tile_e = (const PG8_LAS int*)tile_e; S.dt.init(ctl + CW_Q9, (PG8_LAS int*)(lds + QW_OFF), S.so.nwg, G);
        pg8::EpiFp8 E{Y8, DM, b_down, DM, WSC_INV, (PG8_LAS float*)(lds + LOGIT_OFF)};
        pg8::gemm_phase<pg8::EpiFp8, pg8::MoeOrder, true, true, true>((PG8_LAS unsigned char*)lds + RING_OFF, DM / 2, (const char*)Hact8, (const char*)Wd8, S, E);
        }
        if (BOTH(9)) GRID_BAR();
    }

    if (IN(10)) { PHASE_REP(10) {
        PHASE_LANE();
        moe_tables(gcnt, tile_e, ppad, ecnt, tid);
        f32x4 fw[8];
#pragma unroll
        for (int j = 0; j < 4; ++j) { fw[2 * j] = *(const f32x4*)(final_norm_w + 8 * (lane + 64 * j)); fw[2 * j + 1] = *(const f32x4*)(final_norm_w + 8 * (lane + 64 * j) + 4); }
        for (int row = gw; row < MTOK; row += NGW) {
            const f32x4 gv = *(const f32x4*)(Gate + (size_t)row * 4);
            const int p0 = ppad[Eidx[(size_t)row * 4 + 0]] + Rank[(size_t)row * 4 + 0], p1 = ppad[Eidx[(size_t)row * 4 + 1]] + Rank[(size_t)row * 4 + 1];
            const int p2 = ppad[Eidx[(size_t)row * 4 + 2]] + Rank[(size_t)row * 4 + 2], p3 = ppad[Eidx[(size_t)row * 4 + 3]] + Rank[(size_t)row * 4 + 3];
            v4u xq[4]; v2u yq[4][4];
#pragma unroll
            for (int j = 0; j < 4; ++j) xq[j] = ((const v4u*)(X1 + (size_t)row * DM))[lane + 64 * j];
#pragma unroll
            for (int j = 0; j < 4; ++j) { yq[0][j] = ((const v2u*)(Y8 + (size_t)p0 * DM))[lane + 64 * j]; yq[1][j] = ((const v2u*)(Y8 + (size_t)p1 * DM))[lane + 64 * j];
                yq[2][j] = ((const v2u*)(Y8 + (size_t)p2 * DM))[lane + 64 * j]; yq[3][j] = ((const v2u*)(Y8 + (size_t)p3 * DM))[lane + 64 * j]; }
            __builtin_amdgcn_sched_barrier(0);
            float v[4][8]; float ss = 0.f;
#pragma unroll
            for (int j = 0; j < 4; ++j) { const v4u q = xq[j]; v[j][0] = bflo(q.x); v[j][1] = bfhi(q.x); v[j][2] = bflo(q.y); v[j][3] = bfhi(q.y); v[j][4] = bflo(q.z); v[j][5] = bfhi(q.z); v[j][6] = bflo(q.w); v[j][7] = bfhi(q.w);
#pragma unroll
                for (int k = 0; k < 4; ++k) { const float g = gv[k]; const v2u y = yq[k][j];
                    const f32x2 a = __builtin_amdgcn_cvt_pk_f32_fp8((int)y.x, false), b = __builtin_amdgcn_cvt_pk_f32_fp8((int)y.x, true), c = __builtin_amdgcn_cvt_pk_f32_fp8((int)y.y, false), d = __builtin_amdgcn_cvt_pk_f32_fp8((int)y.y, true);
                    v[j][0] += g * a.x; v[j][1] += g * a.y; v[j][2] += g * b.x; v[j][3] += g * b.y; v[j][4] += g * c.x; v[j][5] += g * c.y; v[j][6] += g * d.x; v[j][7] += g * d.y; }
#pragma unroll
                for (int i = 0; i < 8; ++i) ss += v[j][i] * v[j][i]; }
            const float rstd = rsqrtf(wave_sum(ss) * (1.f / 2048.f) + NORM_EPS);
            float* orow = out + (size_t)row * DM;
#pragma unroll
            for (int j = 0; j < 4; ++j) { const f32x4 wa = fw[2 * j], wb = fw[2 * j + 1]; const int c = 8 * (lane + 64 * j);
                f32x4 o0 = {v[j][0] * rstd * wa.x, v[j][1] * rstd * wa.y, v[j][2] * rstd * wa.z, v[j][3] * rstd * wa.w}, o1 = {v[j][4] * rstd * wb.x, v[j][5] * rstd * wb.y, v[j][6] * rstd * wb.z, v[j][7] * rstd * wb.w};
                *(f32x4*)(orow + c) = o0; *(f32x4*)(orow + c + 4) = o1; }
        }
        }
    }
#undef IN
#undef BOTH
}

extern "C" void kernel_launch(void* const* d_in, const int* in_sizes, int n_in, void* d_out, int out_size, void* d_ws, size_t ws_size, hipStream_t stream) {
    static int grid = 0;
    if (grid == 0) {
        if (n_in != 15 || in_sizes[0] != MTOK * DM || out_size != MTOK * DM || ws_size < WS_END) { fprintf(stderr, "kernel_launch: unexpected shapes / workspace (n_in %d, ws %zu < %zu); nothing launched\n", n_in, ws_size, (size_t)WS_END); grid = -1; return; }
        int dev = 0, cus = 0, per_cu = 0;
        if (hipGetDevice(&dev) != hipSuccess || hipDeviceGetAttribute(&cus, hipDeviceAttributeMultiprocessorCount, dev) != hipSuccess) { grid = -1; return; }
        if (hipFuncSetAttribute((const void*)mk_fwd, hipFuncAttributeMaxDynamicSharedMemorySize, LDS_BYTES) != hipSuccess) { fprintf(stderr, "kernel_launch: hipFuncSetAttribute failed\n"); grid = -1; return; }
        if (hipOccupancyMaxActiveBlocksPerMultiprocessor(&per_cu, (const void*)mk_fwd, NWAVES * 64, LDS_BYTES) != hipSuccess || per_cu < 1) fprintf(stderr, "kernel_launch: occupancy query reports %d blocks per CU\n", per_cu);
        (void)hipGetLastError();
        grid = cus;
    }
    if (grid < 0) return;
    if (hipMemsetAsync((char*)d_ws + WS_CTL, 0, CTL_ZERO_BYTES, stream) != hipSuccess) return;
    Args a{};
    for (int i = 0; i < 15; ++i) a.in[i] = (const float*)d_in[i];
    a.out = (float*)d_out; a.ws = (unsigned char*)d_ws;
#if MK_SPLIT
    for (int k = 0; k < N_PHASES; ++k) { a.ph_lo = k; a.ph_hi = k + 1; hipLaunchKernelGGL(mk_fwd, dim3(grid), dim3(NWAVES * 64), LDS_BYTES, stream, a); }
#else
    a.ph_lo = 0; a.ph_hi = N_PHASES;
    hipLaunchKernelGGL(mk_fwd, dim3(grid), dim3(NWAVES * 64), LDS_BYTES, stream, a);
#endif
    const hipError_t le = hipPeekAtLastError();
    if (le != hipSuccess) fprintf(stderr, "kernel_launch: launch failed: %s\n", hipGetErrorName(le));
}
```

```cpp
#include <hip/hip_runtime.h>
#include <hip/hip_bf16.h>
#include <cstdio>
#include <cstdint>
#include <cmath>

#ifndef MK_SPLIT
#define MK_SPLIT 0
#endif

namespace pg8 {
#define PG8_LAS __attribute__((address_space(3)))
typedef unsigned short bf16_t;
typedef short bf16x8 __attribute__((ext_vector_type(8)));
typedef float f32x4 __attribute__((ext_vector_type(4)));
typedef unsigned u32x4 __attribute__((ext_vector_type(4)));
typedef unsigned u32x2 __attribute__((ext_vector_type(2)));
constexpr int BM = 256, BK = 64, HALF = 128, HTB = HALF * BK * 2  , STAGE_BYTES = 8 * HTB, NXCD = 8, WGM = 8;

__host__ __device__ __forceinline__ int lds_byte(int r, int c) { const int st = (r >> 4) * 2 + (c >> 5), rr = r & 15, cc = c & 31, ob = rr * 64 + cc * 2; return st * 1024 + (ob ^ (((ob >> 9) & 1) << 5)); }
__host__ __device__ __forceinline__ void stage_rc(int b, int& R, int& C) { const int st = b / 1024, sb = b % 1024, swz = sb ^ (((sb >> 9) & 1) << 5); R = (st >> 1) * 16 + swz / 64; C = (st & 1) * 32 + (swz % 64) / 2; }
__host__ __device__ __forceinline__ int perm32(int rho) { const int n = rho >> 4, i = rho & 15; return 8 * (i >> 2) + 4 * n + (i & 3); }

struct Unit { int pm, pn, e, r0, cnt; };

struct StaticOrder {
    int nM, nN, nwg, G, c;
    __device__ __forceinline__ void init(int nM_, int nN_, int G_, int c_) { nM = nM_; nN = nN_; nwg = nM * nN; G = G_; c = c_; }
    __device__ __forceinline__ bool next(int i, Unit& u) const { return at((long)i * G + c, u); }
    __device__ __forceinline__ bool at(const long L, Unit& u) const {
        if (L >= nwg) return false;
        int wgid = (int)L; { const int q = nwg / NXCD, r = nwg % NXCD, xcd = wgid % NXCD, off = wgid / NXCD; wgid = (xcd < r ? xcd * (q + 1) : r * (q + 1) + (xcd - r) * q) + off; }
        const int nig = WGM * nN, gid = wgid / nig, fm = gid * WGM, gsz = (nM - fm) < WGM ? (nM - fm) : WGM;
        u.pm = fm + ((wgid % nig) % gsz); u.pn = (wgid % nig) / gsz; u.e = 0; u.r0 = 0; u.cnt = 0; return true;
    }
    __device__ __forceinline__ int apos(const Unit& u) const { return u.pm; }
    __device__ __forceinline__ int bpos(const Unit& u) const { return u.pn; }
    __device__ __forceinline__ void a_ready(const Unit&) const {}
    __device__ __forceinline__ void done(const Unit&) const {}
};
struct BalancedOrder {
    StaticOrder so; int n_long, r_all, r_extra;
    __device__ __forceinline__ void init(int nM_, int nN_, int G_, int c_, int n_long_, int long_cost, int unit_cost) {
        so.init(nM_, nN_, G_, c_); n_long = n_long_;
        int k = (n_long > 0 && n_long < G_) ? long_cost / unit_cost : 0; int ra = (so.nwg - (G_ - n_long) * k) / G_;
        if (k > 0 && ra >= 0 && ra * G_ + (G_ - n_long) * k == so.nwg) { r_all = ra; r_extra = k; } else { r_all = (so.nwg + G_ - 1) / G_; r_extra = 0; n_long = 0; }
    }
    __device__ __forceinline__ bool next(int i, Unit& u) const {
        if (r_extra == 0) return so.next(i, u);
        long L;
        if (i < r_all) L = (long)i * so.G + so.c; else if (so.c >= n_long && i < r_all + r_extra) L = (long)r_all * so.G + (long)(i - r_all) * (so.G - n_long) + (so.c - n_long); else return false;
        if (L >= so.nwg) return false;
        StaticOrder t = so; t.c = 0; t.G = 1; return t.next((int)L, u);
    }
    __device__ __forceinline__ int apos(const Unit& u) const { return u.pm; }
    __device__ __forceinline__ int bpos(const Unit& u) const { return u.pn; }
    __device__ __forceinline__ void a_ready(const Unit&) const {}
    __device__ __forceinline__ void done(const Unit&) const {}
};
struct DynTail {
    unsigned* qh; PG8_LAS int* qw; int r_s; mutable unsigned pend; mutable int last_i;
    __device__ __forceinline__ void init(unsigned* qh_, PG8_LAS int* qw_, int nwg, int G, int tail = 2) { qh = qh_; qw = qw_; const int ra = nwg / G; r_s = ra >= 2 ? (ra - tail > 2 ? ra - tail : 2) : 0x3fffffff; pend = 0u; last_i = 0; }
    __device__ __forceinline__ long pos(int i, int G, int c) const {
        long L = (long)i * G + c;
        if (i >= r_s) L = (long)r_s * G + __builtin_amdgcn_readfirstlane(*qw);
        last_i = i;
        if (i >= r_s - 1 && threadIdx.x == 0) pend = __hip_atomic_fetch_add(qh, 1u, __ATOMIC_RELAXED, __HIP_MEMORY_SCOPE_AGENT);
        return L;
    }
    __device__ __forceinline__ void publish() const { if (last_i >= r_s - 1 && threadIdx.x == 0) *qw = (int)pend; }
};
struct DynOrder {
    StaticOrder so; DynTail dt;
    __device__ __forceinline__ void init(int nM_, int nN_, int G_, int c_, unsigned* qh, PG8_LAS int* qw, int tail) { so.init(nM_, nN_, G_, c_); dt.init(qh, qw, so.nwg, G_, tail); }
    __device__ __forceinline__ bool next(int i, Unit& u) const { return so.at(dt.pos(i, so.G, so.c), u); }
    __device__ __forceinline__ int apos(const Unit& u) const { return u.pm; }
    __device__ __forceinline__ int bpos(const Unit& u) const { return u.pn; }
    __device__ __forceinline__ void a_ready(const Unit&) const { dt.publish(); }
    __device__ __forceinline__ void done(const Unit&) const {}
};
struct MoeOrder {
    StaticOrder so; const PG8_LAS int* tile_e; DynTail dt;
    __device__ __forceinline__ bool next(int i, Unit& u) const { if (!so.at(dt.pos(i, so.G, so.c), u)) return false; u.e = __builtin_amdgcn_readfirstlane(tile_e[u.pm]); return true; }
    __device__ __forceinline__ int apos(const Unit& u) const { return u.pm; }
    __device__ __forceinline__ int bpos(const Unit& u) const { return u.e * so.nN + u.pn; }
    __device__ __forceinline__ void a_ready(const Unit&) const { dt.publish(); }
    __device__ __forceinline__ void done(const Unit&) const {}
};

struct MoeGatherOrder {
    StaticOrder so; const PG8_LAS int* tile_e; const PG8_LAS int* ppad; const PG8_LAS int* ecnt; const int* tokof; PG8_LAS int* tokbuf; DynTail dt;
    __device__ __forceinline__ bool next(int i, Unit& u) const { if (!so.at(dt.pos(i, so.G, so.c), u)) return false; u.e = __builtin_amdgcn_readfirstlane(tile_e[u.pm]);
        u.r0 = 256 * (u.pm - (__builtin_amdgcn_readfirstlane(ppad[u.e]) >> 8)); u.cnt = __builtin_amdgcn_readfirstlane(ecnt[u.e]); return true; }
    __device__ __forceinline__ int apos(const Unit&) const { return 0; }
    __device__ __forceinline__ int bpos(const Unit& u) const { return u.e * so.nN + u.pn; }
    __device__ __forceinline__ void a_ready(const Unit&) const { dt.publish(); }
    __device__ __forceinline__ void done(const Unit&) const {}
};

__device__ __forceinline__ unsigned cvt_pk_bf16(float lo, float hi) { unsigned r; asm volatile("v_cvt_pk_bf16_f32 %0, %1, %2" : "=v"(r) : "v"(lo), "v"(hi)); return r; }

typedef int v8i_t __attribute__((ext_vector_type(8)));
typedef int v4i_t __attribute__((ext_vector_type(4)));
__device__ __forceinline__ f32x4 mfma_f8(bf16x8 b0, bf16x8 b1, bf16x8 a0, bf16x8 a1, f32x4 c) {
    const v4i_t x0 = __builtin_bit_cast(v4i_t, b0), x1 = __builtin_bit_cast(v4i_t, b1), y0 = __builtin_bit_cast(v4i_t, a0), y1 = __builtin_bit_cast(v4i_t, a1);
    const v8i_t X = {x0.x, x0.y, x0.z, x0.w, x1.x, x1.y, x1.z, x1.w}, Y = {y0.x, y0.y, y0.z, y0.w, y1.x, y1.y, y1.z, y1.w};
    return __builtin_amdgcn_mfma_scale_f32_16x16x128_f8f6f4(X, Y, c, 0, 0, 0, 0x7F7F7F7F, 0, 0x7F7F7F7F);
}
__device__ __forceinline__ unsigned pk4_fp8(float a, float b, float c, float d) { int p = __builtin_amdgcn_cvt_pk_fp8_f32(a, b, 0, false); p = __builtin_amdgcn_cvt_pk_fp8_f32(c, d, p, true); return (unsigned)p; }

struct EpiBf16 {
    static constexpr bool PERM = true, AFTER_DRAIN = false, BIAS_DMA = false;
    bf16_t* O; int ldc; const float* bias; int bias_estride; float scale;
    __device__ __forceinline__ void operator()(const f32x4 (&acc)[2][2][4][2], const Unit& u, int wr, int wc, int fr, int fq) const {
        const int row0 = u.pm * BM + wr * 64 + fr; const int col0 = u.pn * BM + wc * 32 + 8 * fq;
        f32x4 bv[2][2];
#pragma unroll
        for (int bj = 0; bj < 2; ++bj)
#pragma unroll
            for (int n = 0; n < 2; ++n) bv[bj][n] = bias ? *(const f32x4*)(bias + (size_t)u.e * bias_estride + col0 + bj * HALF + 4 * n) : (f32x4){0.f, 0.f, 0.f, 0.f};
#pragma unroll
        for (int ai = 0; ai < 2; ++ai)
#pragma unroll
            for (int m = 0; m < 4; ++m) { bf16_t* rowp = O + (size_t)(row0 + ai * HALF + m * 16) * ldc + col0;
#pragma unroll
                for (int bj = 0; bj < 2; ++bj) { const f32x4 v0 = acc[ai][bj][m][0] * scale + bv[bj][0], v1 = acc[ai][bj][m][1] * scale + bv[bj][1];
                    u32x4 w; w.x = cvt_pk_bf16(v0[0], v0[1]); w.y = cvt_pk_bf16(v0[2], v0[3]); w.z = cvt_pk_bf16(v1[0], v1[1]); w.w = cvt_pk_bf16(v1[2], v1[3]);
                    *(u32x4*)(rowp + bj * HALF) = w; } }
    }
};
struct EpiInProj {
    static constexpr bool PERM = true, AFTER_DRAIN = false, BIAS_DMA = false;
    bf16_t* P; bf16_t* PB; int pn_off; float scale;
    __device__ __forceinline__ void operator()(const f32x4 (&acc)[2][2][4][2], const Unit& u, int wr, int wc, int fr, int fq) const {
        const int row0 = u.pm * BM + wr * 64 + fr; const int upn = u.pn + pn_off;
        if (upn < 9) {
            const int col0 = upn * BM + wc * 32 + 8 * fq;
#pragma unroll
            for (int ai = 0; ai < 2; ++ai)
#pragma unroll
                for (int m = 0; m < 4; ++m) { bf16_t* rowp = P + (size_t)(row0 + ai * HALF + m * 16) * 2304 + col0;
#pragma unroll
                    for (int bj = 0; bj < 2; ++bj) { const f32x4 v0 = acc[ai][bj][m][0], v1 = acc[ai][bj][m][1];
                        u32x4 w; w.x = cvt_pk_bf16(v0[0], v0[1]); w.y = cvt_pk_bf16(v0[2], v0[3]); w.z = cvt_pk_bf16(v1[0], v1[1]); w.w = cvt_pk_bf16(v1[2], v1[3]);
                        *(u32x4*)(rowp + bj * HALF) = w; } }
        } else {
            const int cb0 = (upn - 9) * BM, g = cb0 / 1536, rem0 = cb0 % 1536, kind = rem0 / 512, dsh = 2 * g, b = (u.pm * BM) >> 14;
            const int d0 = (32 * wc + 8 * fq) & 63;
#pragma unroll
            for (int bj = 0; bj < 2; ++bj) { const int hh = ((rem0 & 511) + 128 * bj + 32 * wc) >> 6;
                bf16_t* base = PB + ((size_t)((((g * 3 + kind) * 2 + b) * 8 + hh)) << 20) + d0;
#pragma unroll
                for (int ai = 0; ai < 2; ++ai)
#pragma unroll
                    for (int m = 0; m < 4; ++m) { const int s = (row0 + ai * HALF + m * 16) & 16383; const int rr = ((s & ((1 << dsh) - 1)) << (14 - dsh)) + (s >> dsh);
                        const f32x4 v0 = acc[ai][bj][m][0] * scale, v1 = acc[ai][bj][m][1] * scale;
                        u32x4 w; w.x = cvt_pk_bf16(v0[0], v0[1]); w.y = cvt_pk_bf16(v0[2], v0[3]); w.z = cvt_pk_bf16(v1[0], v1[1]); w.w = cvt_pk_bf16(v1[2], v1[3]);
                        *(u32x4*)(base + (size_t)rr * 64) = w; } }
        }
    }
};
struct EpiResidBf16 {
    static constexpr bool PERM = true, AFTER_DRAIN = false, BIAS_DMA = false;
    const float* X; bf16_t* O; int ldc;
    __device__ __forceinline__ void operator()(const f32x4 (&acc)[2][2][4][2], const Unit& u, int wr, int wc, int fr, int fq) const {
        const int row0 = u.pm * BM + wr * 64 + fr; const int col0 = u.pn * BM + wc * 32 + 8 * fq;
#pragma unroll
        for (int ai = 0; ai < 2; ++ai)
#pragma unroll
            for (int m = 0; m < 4; ++m) { const size_t off = (size_t)(row0 + ai * HALF + m * 16) * ldc + col0;
#pragma unroll
                for (int bj = 0; bj < 2; ++bj) { const f32x4 x0 = *(const f32x4*)(X + off + bj * HALF), x1 = *(const f32x4*)(X + off + bj * HALF + 4);
                    const f32x4 v0 = x0 + acc[ai][bj][m][0], v1 = x1 + acc[ai][bj][m][1];
                    u32x4 w; w.x = cvt_pk_bf16(v0[0], v0[1]); w.y = cvt_pk_bf16(v0[2], v0[3]); w.z = cvt_pk_bf16(v1[0], v1[1]); w.w = cvt_pk_bf16(v1[2], v1[3]);
                    *(u32x4*)(O + off + bj * HALF) = w; } }
    }
};
struct EpiFp8 {
    static constexpr bool PERM = true, AFTER_DRAIN = false, BIAS_DMA = true;
    unsigned char* O; int ldc; const float* bias; int bias_estride; float scale; PG8_LAS float* bbuf;
    __device__ __forceinline__ void bias_dma(const Unit& u, int ui, int lane) const {
        __builtin_amdgcn_global_load_lds((const unsigned*)(bias + (size_t)u.e * bias_estride + u.pn * BM + 4 * lane), (PG8_LAS unsigned*)(bbuf + (ui & 1) * 256), 16, 0, 0); }
    __device__ __forceinline__ void operator()(const f32x4 (&acc)[2][2][4][2], const Unit& u, int wr, int wc, int fr, int fq, int ui) const {
        const int row0 = u.pm * BM + wr * 64 + fr; const int col0 = u.pn * BM + wc * 32 + 8 * fq;
        const PG8_LAS float* bb = bbuf + (ui & 1) * 256 + wc * 32 + 8 * fq;
        f32x4 bv[2][2];
#pragma unroll
        for (int bj = 0; bj < 2; ++bj)
#pragma unroll
            for (int n = 0; n < 2; ++n) bv[bj][n] = *(const PG8_LAS f32x4*)(bb + bj * HALF + 4 * n);
#pragma unroll
        for (int ai = 0; ai < 2; ++ai)
#pragma unroll
            for (int m = 0; m < 4; ++m) { unsigned char* rowp = O + (size_t)(row0 + ai * HALF + m * 16) * ldc + col0;
#pragma unroll
                for (int bj = 0; bj < 2; ++bj) { const f32x4 v0 = acc[ai][bj][m][0] * scale + bv[bj][0], v1 = acc[ai][bj][m][1] * scale + bv[bj][1];
                    u32x2 w; w.x = pk4_fp8(v0[0], v0[1], v0[2], v0[3]); w.y = pk4_fp8(v1[0], v1[1], v1[2], v1[3]);
                    *(u32x2*)(rowp + bj * HALF) = w; } }
    }
};
struct EpiSwiglu {
    static constexpr bool PERM = true, AFTER_DRAIN = false, BIAS_DMA = true;
    unsigned char* H; const float* bgu; float scale; PG8_LAS float* bbuf;
    __device__ __forceinline__ void bias_dma(const Unit& u, int ui, int lane) const {
        __builtin_amdgcn_global_load_lds((const unsigned*)(bgu + (size_t)u.e * 4096 + u.pn * HALF + (lane >> 5) * 2048 + 4 * (lane & 31)), (PG8_LAS unsigned*)(bbuf + (ui & 1) * 256), 16, 0, 0); }
    __device__ __forceinline__ float act(float g, float up) const {
        g = fminf(g, 7.0f); up = fminf(fmaxf(up, -7.0f), 7.0f);
        const float sg = __builtin_amdgcn_rcpf(1.0f + __builtin_amdgcn_exp2f(-1.702f * 1.4426950408889634f * g));
        return (up + 1.0f) * g * sg;
    }
    __device__ __forceinline__ void operator()(const f32x4 (&acc)[2][2][4][2], const Unit& u, int wr, int wc, int fr, int fq, int ui) const {
        const int row0 = u.pm * BM + wr * 64 + fr; const int colh = u.pn * HALF + wc * 32 + 8 * fq;
        const PG8_LAS float* bg = bbuf + (ui & 1) * 256 + wc * 32 + 8 * fq;
        const f32x4 bg0 = *(const PG8_LAS f32x4*)(bg), bg1 = *(const PG8_LAS f32x4*)(bg + 4), bu0 = *(const PG8_LAS f32x4*)(bg + 128), bu1 = *(const PG8_LAS f32x4*)(bg + 132);
#pragma unroll
        for (int ai = 0; ai < 2; ++ai)
#pragma unroll
            for (int m = 0; m < 4; ++m) { unsigned char* rowp = H + (size_t)(row0 + ai * HALF + m * 16) * 2048 + colh;
                const f32x4 g0 = acc[ai][0][m][0] * scale + bg0, g1 = acc[ai][0][m][1] * scale + bg1, u0 = acc[ai][1][m][0] * scale + bu0, u1 = acc[ai][1][m][1] * scale + bu1;
                u32x2 w; w.x = pk4_fp8(act(g0[0], u0[0]), act(g0[1], u0[1]), act(g0[2], u0[2]), act(g0[3], u0[3]));
                w.y = pk4_fp8(act(g1[0], u1[0]), act(g1[1], u1[1]), act(g1[2], u1[2]), act(g1[3], u1[3]));
                *(u32x2*)rowp = w; }
    }
};

template <class Epi, class Sched, bool ALIGN_EPI = false, bool SP2 = false, bool F8 = false, bool GATHER = false>
__device__ __forceinline__ void gemm_phase(PG8_LAS unsigned char* lds, const int K, const char* Abase, const char* Bbase, const Sched& S, const Epi& E) {
    const int tid = threadIdx.x, wid = __builtin_amdgcn_readfirstlane(tid >> 6), lane = tid & 63, wr = wid >> 2, wc = wid & 3, fr = lane & 15, fq = lane >> 4;
    const int nt = K / BK;
    static_assert(SP2, "only the two-super-phase loop is kept");
    unsigned voffB[2], vAc[2][2], vAn[2][2]; int RA[2]; unsigned CA2[2];
#pragma unroll
    for (int i = 0; i < 2; ++i) { int R, C; stage_rc(tid * 16 + i * 8192, R, C); const int Rb = Epi::PERM ? ((R & ~31) + perm32(R & 31)) : R;
        RA[i] = R; CA2[i] = (unsigned)C * 2u; voffB[i] = (unsigned)(Rb * K + C) * 2u; }
    const size_t kstep = (size_t)(BK * 2);
    const size_t hstep = (size_t)HALF * K * 2;
    const size_t tstep = 2 * hstep;
#pragma unroll
    for (int h = 0; h < 2; ++h)
#pragma unroll
        for (int i = 0; i < 2; ++i) vAc[h][i] = vAn[h][i] = (unsigned)(RA[i] * K) * 2u + CA2[i] + (unsigned)(h * hstep);
#define PG8_TOKDMA(slot, U) do { if (wid == 0) __builtin_amdgcn_global_load_lds((const unsigned*)(S.tokof + (size_t)(U).e * 32768 + (U).r0 + 4 * lane), (PG8_LAS unsigned*)(S.tokbuf + (slot) * 256), 16, 0, 0); } while (0)
#define PG8_TOKOFF(dst, slot, U) do { const PG8_LAS int* tb_ = S.tokbuf + (slot) * 256; _Pragma("unroll") for (int h_ = 0; h_ < 2; ++h_) _Pragma("unroll") for (int i_ = 0; i_ < 2; ++i_) { \
        const int rk_ = 128 * h_ + RA[i_]; int tk_ = tb_[rk_]; tk_ = ((U).r0 + rk_ < (U).cnt) ? tk_ : 0; dst[h_][i_] = (unsigned)tk_ * (unsigned)(2 * K) + CA2[i_]; } } while (0)
    const unsigned ldsw = (unsigned)wid * 1024u;
    const int aoff = lds_byte(wr * 64 + fr, fq * 8), boff = lds_byte(wc * 32 + fr, fq * 8);
#define PG8_SA(b, h) (((b) * 2 + (h)) * HTB)
#define PG8_SB(b, h) ((4 + (b) * 2 + (h)) * HTB)
#define PG8_STAGE(bufoff, RS, goff, voff) do { _Pragma("unroll") for (int _i = 0; _i < 2; ++_i) \
        __builtin_amdgcn_raw_ptr_buffer_load_lds(RS, (PG8_LAS void*)(lds + (bufoff) + ldsw + _i * 8192), 16, (voff)[_i], (goff), 0, 0); } while (0)
#define PG8_LDA(dst, b, h) do { if constexpr (F8) { _Pragma("unroll") for (int m = 0; m < 4; ++m) { dst##8[m].lo = *(const PG8_LAS v4i_t*)(lds + PG8_SA(b, h) + aoff + m * 2048); dst##8[m].hi = *(const PG8_LAS v4i_t*)(lds + PG8_SA(b, h) + aoff + m * 2048 + 1024); } } \
    else { _Pragma("unroll") for (int m = 0; m < 4; ++m) _Pragma("unroll") for (int k = 0; k < 2; ++k) dst[m][k] = *(const PG8_LAS bf16x8*)(lds + PG8_SA(b, h) + aoff + m * 2048 + k * 1024); } } while (0)
#define PG8_LDB(dst, b, h) do { if constexpr (F8) { _Pragma("unroll") for (int n = 0; n < 2; ++n) { dst##8[n].lo = *(const PG8_LAS v4i_t*)(lds + PG8_SB(b, h) + boff + n * 2048); dst##8[n].hi = *(const PG8_LAS v4i_t*)(lds + PG8_SB(b, h) + boff + n * 2048 + 1024); } } \
    else { _Pragma("unroll") for (int n = 0; n < 2; ++n) _Pragma("unroll") for (int k = 0; k < 2; ++k) dst[n][k] = *(const PG8_LAS bf16x8*)(lds + PG8_SB(b, h) + boff + n * 2048 + k * 1024); } } while (0)
#define PG8_MMA(ai, bj, At, Bt) do { __builtin_amdgcn_s_setprio(1); if constexpr (F8) { _Pragma("unroll") for (int m = 0; m < 4; ++m) _Pragma("unroll") for (int n = 0; n < 2; ++n) \
        asm volatile("v_mfma_f32_16x16x128_f8f6f4 %0, %1, %2, %0" : "+v"(acc[ai][bj][m][n]) : "v"(Bt##8[n]), "v"(At##8[m])); } else { _Pragma("unroll") for (int m = 0; m < 4; ++m) _Pragma("unroll") for (int n = 0; n < 2; ++n) _Pragma("unroll") for (int k = 0; k < 2; ++k) \
        acc[ai][bj][m][n] = __builtin_amdgcn_mfma_f32_16x16x32_bf16(Bt[n][k], At[m][k], acc[ai][bj][m][n], 0, 0, 0); } __builtin_amdgcn_s_setprio(0); } while (0)
#define PG8_WAIT_V(n) asm volatile("s_waitcnt vmcnt(" #n ")" ::: "memory")
#define PG8_WAIT_L(n) asm volatile("s_waitcnt lgkmcnt(" #n ")" ::: "memory")
#define PG8_BAR __builtin_amdgcn_s_barrier()
#define PG8_SCHED __builtin_amdgcn_sched_barrier(0)
    Unit cur, nxt; int ui = 0;
    if (!S.next(0, cur)) return;
    f32x4 acc[2][2][4][2];
#pragma unroll
    for (int a = 0; a < 2; ++a)
#pragma unroll
        for (int b = 0; b < 2; ++b)
#pragma unroll
            for (int m = 0; m < 4; ++m)
#pragma unroll
                for (int n = 0; n < 2; ++n) acc[a][b][m][n] = (f32x4){0.f, 0.f, 0.f, 0.f};
    bf16x8 At[4][2], B0[2][2], B1[2][2]; v8i_t At8[4], B08[2], B18[2];
    const __amdgpu_buffer_rsrc_t rsA = __builtin_amdgcn_make_buffer_rsrc((void*)Abase, 0, 0x7fffffff, 0x00020000), rsB = __builtin_amdgcn_make_buffer_rsrc((void*)Bbase, 0, 0x7fffffff, 0x00020000);
    unsigned cA = (unsigned)((size_t)S.apos(cur) * tstep), cB = (unsigned)((size_t)S.bpos(cur) * tstep);
    S.a_ready(cur);
    if constexpr (GATHER) { PG8_TOKDMA(0, cur); PG8_WAIT_V(0); PG8_BAR; PG8_TOKOFF(vAc, 0, cur); PG8_WAIT_L(0); }
    {
        PG8_STAGE(PG8_SB(0, 0), rsB, cB, voffB); PG8_STAGE(PG8_SB(0, 1), rsB, cB + (unsigned)hstep, voffB); PG8_STAGE(PG8_SA(0, 0), rsA, cA, vAc[0]); PG8_STAGE(PG8_SA(0, 1), rsA, cA, vAc[1]);
        if (wr == 1) PG8_BAR;
        PG8_WAIT_V(2); PG8_BAR;
        PG8_STAGE(PG8_SB(1, 0), rsB, cB + (unsigned)kstep, voffB); PG8_STAGE(PG8_SA(1, 0), rsA, cA + (unsigned)kstep, vAc[0]); PG8_STAGE(PG8_SB(1, 1), rsB, cB + (unsigned)(hstep + kstep), voffB);
        PG8_WAIT_V(6); PG8_BAR;
    }
    for (;;) {
        const bool has_next = S.next(ui + 1, nxt);
        const unsigned nA = has_next ? (unsigned)((size_t)S.apos(nxt) * tstep) : cA; const unsigned nB = has_next ? (unsigned)((size_t)S.bpos(nxt) * tstep) : cB;
        if constexpr (Epi::BIAS_DMA) { if (wid == 1) E.bias_dma(cur, ui, lane); }
        if constexpr (GATHER) { if (has_next) PG8_TOKDMA((ui + 1) & 1, nxt); }
        for (int t = 0; t < nt; t += 2) {
            const bool last = (t == nt - 2);
            const unsigned a1 = cA + (unsigned)((t + 1) * kstep);
            const unsigned a2 = last ? nA : cA + (unsigned)((t + 2) * kstep); const unsigned b2 = last ? nB : cB + (unsigned)((t + 2) * kstep);
            const unsigned a3 = a2 + (unsigned)kstep; const unsigned b3 = b2 + (unsigned)kstep;
            if (last && has_next) S.a_ready(nxt);
            if constexpr (GATHER) { if (last && has_next) { PG8_TOKOFF(vAn, (ui + 1) & 1, nxt); } }
            const unsigned v20 = last ? vAn[0][0] : vAc[0][0], v21 = last ? vAn[0][1] : vAc[0][1], v30 = last ? vAn[1][0] : vAc[1][0], v31 = last ? vAn[1][1] : vAc[1][1];
            const unsigned vx0[2] = {v20, v21}, vx1[2] = {v30, v31};
            PG8_LDB(B0, 0, 0); PG8_LDB(B1, 0, 1); PG8_SCHED; PG8_LDA(At, 0, 0); PG8_STAGE(PG8_SA(1, 1), rsA, a1, vAc[1]);
            PG8_WAIT_V(8); PG8_WAIT_L(0); PG8_BAR; PG8_MMA(0, 0, At, B0); PG8_MMA(0, 1, At, B1); PG8_BAR; PG8_SCHED;
            PG8_LDA(At, 0, 1); PG8_STAGE(PG8_SB(0, 0), rsB, b2, voffB); PG8_STAGE(PG8_SB(0, 1), rsB, b2 + (unsigned)hstep, voffB); PG8_STAGE(PG8_SA(0, 0), rsA, a2, vx0);
            PG8_WAIT_V(8); PG8_WAIT_L(0); PG8_BAR; PG8_MMA(1, 0, At, B0); PG8_MMA(1, 1, At, B1); PG8_BAR; PG8_SCHED;
            PG8_LDB(B0, 1, 0); PG8_LDB(B1, 1, 1); PG8_SCHED; PG8_LDA(At, 1, 0); PG8_STAGE(PG8_SA(0, 1), rsA, a2, vx1);
            PG8_WAIT_V(8); PG8_WAIT_L(0); PG8_BAR; PG8_MMA(0, 0, At, B0); PG8_MMA(0, 1, At, B1); PG8_BAR; PG8_SCHED;
            PG8_LDA(At, 1, 1); PG8_STAGE(PG8_SB(1, 0), rsB, b3, voffB); PG8_STAGE(PG8_SB(1, 1), rsB, b3 + (unsigned)hstep, voffB); PG8_STAGE(PG8_SA(1, 0), rsA, a3, vx0);
            PG8_WAIT_V(8); PG8_WAIT_L(0); PG8_BAR; PG8_MMA(1, 0, At, B0); PG8_MMA(1, 1, At, B1); PG8_BAR; PG8_SCHED;
        }
        if constexpr (F8) { asm volatile("s_nop 15\n\ts_nop 15" ::: "memory"); }
        if constexpr (ALIGN_EPI) { if (wr == 0) PG8_BAR; }
        if constexpr (!Epi::AFTER_DRAIN) { if constexpr (Epi::BIAS_DMA) E(acc, cur, wr, wc, fr, fq, ui); else E(acc, cur, wr, wc, fr, fq); S.done(cur); }
        if (!has_next) break;
#pragma unroll
        for (int a = 0; a < 2; ++a)
#pragma unroll
            for (int b = 0; b < 2; ++b)
#pragma unroll
                for (int m = 0; m < 4; ++m)
#pragma unroll
                    for (int n = 0; n < 2; ++n) acc[a][b][m][n] = (f32x4){0.f, 0.f, 0.f, 0.f};
        cur = nxt; cA = nA; cB = nB; ++ui;
        if constexpr (GATHER) { _Pragma("unroll") for (int h = 0; h < 2; ++h) _Pragma("unroll") for (int i = 0; i < 2; ++i) vAc[h][i] = vAn[h][i]; }
        if constexpr (ALIGN_EPI) { if (wr == 1) PG8_BAR; }
    }
    PG8_WAIT_V(0);
    if constexpr (!ALIGN_EPI) { if (wr == 0) PG8_BAR; }
    PG8_BAR;
    if constexpr (Epi::AFTER_DRAIN) { E.fused(acc, cur, wr, wc, fr, fq, lds, wid, lane); S.done(cur); }
#undef PG8_SA
#undef PG8_SB
#undef PG8_STAGE
#undef PG8_TOKDMA
#undef PG8_TOKOFF
#undef PG8_LDA
#undef PG8_LDB
#undef PG8_MMA
#undef PG8_WAIT_V
#undef PG8_WAIT_L
#undef PG8_BAR
#undef PG8_SCHED
}
}

namespace attn_body {
using bf16=__hip_bfloat16;
using bf16x8=__attribute__((ext_vector_type(8)))short;
using s16x4=__attribute__((ext_vector_type(4)))short;
using f32x16=__attribute__((ext_vector_type(16)))float;
using u32x4=__attribute__((ext_vector_type(4)))unsigned;
constexpr int D=64;
constexpr int NW=8,QBLK=32,QB=QBLK*NW,KVBLK=64;
__device__ __forceinline__ int crow(int r,int hi){return (r&3)+8*(r>>2)+4*hi;}
#define SBAR() __builtin_amdgcn_sched_barrier(0)
__device__ __forceinline__ void cmask(f32x16&p0,f32x16&p1,int jb,int qrel,int hi){
  const float NEG=-INFINITY; int kb=64*jb+4*hi;
  #pragma unroll
  for(int r=0;r<16;++r){int kv=kb+(r&3)+8*(r>>2); if(kv>qrel)p0[r]=NEG; if(kv+32>qrel)p1[r]=NEG;}
}

constexpr int NSLOT=6, SLOTB=8192;
constexpr int LDS_K=0, LDS_V=NSLOT*SLOTB, LDS_WS=2*NSLOT*SLOTB, LDS_OST=LDS_K, LDS_BYTES=LDS_WS+NW*64*4;
constexpr float C2=0.125f*1.4426950408889634f;
__device__ __forceinline__ void glds16(const void*gsrc,unsigned lds_dst){
  asm volatile("s_mov_b32 m0, %1\n\ts_nop 0\n\tglobal_load_lds_dwordx4 %0, off"::"v"(gsrc),"s"(lds_dst):"memory","m0");}
__device__ __forceinline__ void glds16s(unsigned long long sbase,unsigned voff,unsigned lds_dst){
  asm volatile("s_mov_b32 m0, %2\n\ts_nop 0\n\tglobal_load_lds_dwordx4 %0, %1"::"v"(voff),"s"(sbase),"s"(lds_dst):"memory","m0");}
__device__ __forceinline__ float max3f(float a,float b,float c){float r;asm("v_max3_f32 %0, %1, %2, %3":"=v"(r):"v"(a),"v"(b),"v"(c));return r;}
__device__ __forceinline__ float max2f(float a,float b){float r;asm("v_max_f32_e32 %0, %1, %2":"=v"(r):"v"(a),"v"(b));return r;}
__device__ __forceinline__ float fadd_s(float a,float b){float r;asm("v_add_f32_e32 %0, %1, %2":"=v"(r):"v"(a),"v"(b));return r;}
__device__ __forceinline__ float fsub_s(float a,float b){float r;asm("v_sub_f32_e32 %0, %1, %2":"=v"(r):"v"(a),"v"(b));return r;}
typedef float f32x2_t __attribute__((ext_vector_type(2))); typedef __bf16 bf16x2_t __attribute__((ext_vector_type(2)));
__device__ __forceinline__ unsigned cvtpk_s(float lo,float hi){f32x2_t v={lo,hi};bf16x2_t b=__builtin_convertvector(v,bf16x2_t);return __builtin_bit_cast(unsigned,b);}
#define WAIT_BAR(N) asm volatile("s_waitcnt vmcnt(" #N ") lgkmcnt(0)\n\ts_barrier":::"memory")

__device__ __forceinline__ void qkt(f32x16&p0,f32x16&p1,const char*Kslot,const bf16x8*qr,const f32x16&negm,int r32,int hi){
  const char*kb=Kslot+hi*1024+r32*16;
  #pragma unroll
  for(int d0=0;d0<4;++d0){
    const bf16x8 b0=*reinterpret_cast<const bf16x8*>(kb+d0*2048);
    const bf16x8 b1=*reinterpret_cast<const bf16x8*>(kb+d0*2048+512);
    if(d0==0){p0=__builtin_amdgcn_mfma_f32_32x32x16_bf16(b0,qr[0],negm,0,0,0);p1=__builtin_amdgcn_mfma_f32_32x32x16_bf16(b1,qr[0],negm,0,0,0);}
    else{p0=__builtin_amdgcn_mfma_f32_32x32x16_bf16(b0,qr[d0],p0,0,0,0);p1=__builtin_amdgcn_mfma_f32_32x32x16_bf16(b1,qr[d0],p1,0,0,0);}}
}
typedef __attribute__((address_space(3))) const char* lds_cptr;
typedef short v4i16_t __attribute__((ext_vector_type(4)));
__device__ __forceinline__ void kload8(bf16x8*kf,lds_cptr kp){
  kf[0]=*(const __attribute__((address_space(3))) bf16x8*)(kp);      kf[1]=*(const __attribute__((address_space(3))) bf16x8*)(kp+512);
  kf[2]=*(const __attribute__((address_space(3))) bf16x8*)(kp+2048); kf[3]=*(const __attribute__((address_space(3))) bf16x8*)(kp+2560);
  kf[4]=*(const __attribute__((address_space(3))) bf16x8*)(kp+4096); kf[5]=*(const __attribute__((address_space(3))) bf16x8*)(kp+4608);
  kf[6]=*(const __attribute__((address_space(3))) bf16x8*)(kp+6144); kf[7]=*(const __attribute__((address_space(3))) bf16x8*)(kp+6656);
}
__device__ __forceinline__ void kload2(bf16x8*kf,lds_cptr kp,int j){ kf[2*j]=*(const __attribute__((address_space(3))) bf16x8*)(kp+j*2048); kf[2*j+1]=*(const __attribute__((address_space(3))) bf16x8*)(kp+j*2048+512); }
__device__ __forceinline__ s16x4 vtr(lds_cptr p){ return __builtin_bit_cast(s16x4,__builtin_amdgcn_ds_read_tr16_b64_v4i16((__attribute__((address_space(3))) v4i16_t*)p)); }
__device__ __forceinline__ float rowmax(const f32x16&p0,const f32x16&p1){
  float a=max3f(p0[0],p0[1],p1[0]),b=max3f(p0[2],p0[3],p1[1]);a=max3f(a,p1[2],p1[3]);
  #pragma unroll
  for(int r=4;r<16;r+=4){a=max3f(a,p0[r],p0[r+1]);b=max3f(b,p0[r+2],p0[r+3]);a=max3f(a,p1[r],p1[r+1]);b=max3f(b,p1[r+2],p1[r+3]);}
  const float m=max2f(a,b);
  auto rr=__builtin_amdgcn_permlane32_swap(__float_as_uint(m),__float_as_uint(m),false,false);
  return max2f(__uint_as_float(rr[0]),__uint_as_float(rr[1]));
}
__device__ __forceinline__ void pv(f32x16*o,int vb,bf16x8 pa0,bf16x8 pa1,bf16x8 pa2,bf16x8 pa3){
  #pragma unroll
  for(int d0=0;d0<2;++d0){s16x4 lo[4],hi[4];
    #pragma unroll
    for(int ks=0;ks<4;++ks){
      asm volatile("ds_read_b64_tr_b16 %0,%1 offset:%c2":"=&v"(lo[ks]):"v"(vb),"i"(d0*4096+ks*1024):"memory");
      asm volatile("ds_read_b64_tr_b16 %0,%1 offset:%c2":"=&v"(hi[ks]):"v"(vb),"i"(d0*4096+ks*1024+512):"memory");}
    asm volatile("s_waitcnt lgkmcnt(0)":::"memory");SBAR();
    #define PK(k) (bf16x8){lo[k][0],lo[k][1],lo[k][2],lo[k][3],hi[k][0],hi[k][1],hi[k][2],hi[k][3]}
    o[d0]=__builtin_amdgcn_mfma_f32_32x32x16_bf16(pa0,PK(0),o[d0],0,0,0);
    o[d0]=__builtin_amdgcn_mfma_f32_32x32x16_bf16(pa1,PK(1),o[d0],0,0,0);
    o[d0]=__builtin_amdgcn_mfma_f32_32x32x16_bf16(pa2,PK(2),o[d0],0,0,0);
    o[d0]=__builtin_amdgcn_mfma_f32_32x32x16_bf16(pa3,PK(3),o[d0],0,0,0);
    #undef PK
  }
}

#ifndef ATTN_STORE16
#define ATTN_STORE16(p,v) (*(u32x4*)(p)=(v))
#endif
typedef _Float16 h2_t __attribute__((ext_vector_type(2))); typedef _Float16 h8_t __attribute__((ext_vector_type(8)));
__device__ __forceinline__ unsigned cvtpk_h(float lo,float hi){f32x2_t v={lo,hi};h2_t b=__builtin_convertvector(v,h2_t);return __builtin_bit_cast(unsigned,b);}
__device__ __forceinline__ void pvh(f32x16*o,int vb,bf16x8 pa0,bf16x8 pa1,bf16x8 pa2,bf16x8 pa3){
  #pragma unroll
  for(int d0=0;d0<2;++d0){s16x4 lo[4],hi[4];
    #pragma unroll
    for(int ks=0;ks<4;++ks){
      asm volatile("ds_read_b64_tr_b16 %0,%1 offset:%c2":"=&v"(lo[ks]):"v"(vb),"i"(d0*4096+ks*1024):"memory");
      asm volatile("ds_read_b64_tr_b16 %0,%1 offset:%c2":"=&v"(hi[ks]):"v"(vb),"i"(d0*4096+ks*1024+512):"memory");}
    asm volatile("s_waitcnt lgkmcnt(0)":::"memory");SBAR();
    #define PKH(k) __builtin_bit_cast(h8_t,(bf16x8){lo[k][0],lo[k][1],lo[k][2],lo[k][3],hi[k][0],hi[k][1],hi[k][2],hi[k][3]})
    o[d0]=__builtin_amdgcn_mfma_f32_32x32x16_f16(__builtin_bit_cast(h8_t,pa0),PKH(0),o[d0],0,0,0);
    o[d0]=__builtin_amdgcn_mfma_f32_32x32x16_f16(__builtin_bit_cast(h8_t,pa1),PKH(1),o[d0],0,0,0);
    o[d0]=__builtin_amdgcn_mfma_f32_32x32x16_f16(__builtin_bit_cast(h8_t,pa2),PKH(2),o[d0],0,0,0);
    o[d0]=__builtin_amdgcn_mfma_f32_32x32x16_f16(__builtin_bit_cast(h8_t,pa3),PKH(3),o[d0],0,0,0);
    #undef PKH
  }
}
template<bool FIXED,int THRL,int PQ,int PK,int PV,int PO,int NT> __device__ __forceinline__ void attn_unit(const bf16*Qu,const bf16*__restrict__ Kh,const bf16*__restrict__ Vh,bf16*Ou,char*shm,float mref){
  const int tid=threadIdx.x,lane=tid&63,r32=lane&31,hi=lane>>5; const int wid=__builtin_amdgcn_readfirstlane(tid>>6);

  const bf16*Qw=Qu+(long)(wid*QBLK)*PQ;

  const unsigned lds0=(unsigned)(uintptr_t)shm;
  float*wsf=(float*)(shm+LDS_WS)+wid*64;
  const unsigned kvo=(unsigned)(lane*PK+wid*8)*2u, vvo=(unsigned)((16*(wid&3)+(lane>>2))*PV+(wid>>2)*32+(lane&3)*8)*2u;
  const unsigned long long kb64=((unsigned long long)(unsigned)__builtin_amdgcn_readfirstlane((int)((unsigned long long)(uintptr_t)Kh>>32))<<32)|(unsigned)__builtin_amdgcn_readfirstlane((int)(unsigned)(uintptr_t)Kh);
  const unsigned long long vb64=((unsigned long long)(unsigned)__builtin_amdgcn_readfirstlane((int)((unsigned long long)(uintptr_t)Vh>>32))<<32)|(unsigned)__builtin_amdgcn_readfirstlane((int)(unsigned)(uintptr_t)Vh);
  const unsigned kdst=lds0+LDS_K+wid*1024, vdst=lds0+LDS_V+wid*1024;
  #define DMA_K(t,slot) glds16s(kb64+(unsigned long long)(t)*(KVBLK*PK*2),kvo,(unsigned)__builtin_amdgcn_readfirstlane(kdst+(slot)))
  #define DMA_V(t,slot) glds16s(vb64+(unsigned long long)(t)*(KVBLK*PV*2),vvo,(unsigned)__builtin_amdgcn_readfirstlane(vdst+(slot)))
  const int vb0=(int)(lds0+LDS_V)+((lane>>4)&1)*32+(lane&3)*8+(4*hi+((lane&15)>>2))*64;
  const char*Kbase=shm+LDS_K; bf16x8 kf[8];
  const lds_cptr shm3=(lds_cptr)shm; const lds_cptr kp0=shm3+LDS_K+hi*1024+r32*16; const lds_cptr vp0=shm3+LDS_V+((lane>>4)&1)*32+(lane&3)*8+(4*hi+((lane&15)>>2))*64;
  static_assert(NT>=8 && NT%2==0,"NT");
  DMA_K(0,0);DMA_V(0,0);DMA_K(1,SLOTB);
  bf16x8 qr[4];
  #pragma unroll
  for(int d0=0;d0<4;++d0)qr[d0]=*reinterpret_cast<const bf16x8*>(&Qw[(long)r32*PQ+d0*16+hi*8]);
  float mhat=0.f,l_reg=0.f;f32x16 o[2];o[0]=f32x16{};o[1]=f32x16{};f32x16 negm=f32x16{}; if constexpr(!FIXED){ asm volatile("":"+v"(negm)); } (void)mref; const f32x16 negc={-4.f,-4.f,-4.f,-4.f,-4.f,-4.f,-4.f,-4.f,-4.f,-4.f,-4.f,-4.f,-4.f,-4.f,-4.f,-4.f}; h2_t hs={(_Float16)0.f,(_Float16)0.f},hs2={(_Float16)0.f,(_Float16)0.f};
  #define QK0(C_,KF_,QR_) do{ if constexpr(FIXED){ asm volatile("v_mfma_f32_32x32x16_bf16 %0, %1, %2, -4.0":"=&v"(C_):"v"(KF_),"v"(QR_)); } else { C_=__builtin_amdgcn_mfma_f32_32x32x16_bf16(KF_,QR_,negm,0,0,0); } }while(0)
  #define NEGM (FIXED?negc:negm)
  const int qrel=wid*QBLK+r32;
  #define CMASK(P0,P1,t) do{}while(0)
  bool resc=false;
  #define START(P0,P1) do{ resc=false; if constexpr(!FIXED){ const float rm=rowmax(P0,P1); \
      const float dl=rm; mhat=fadd_s(mhat,dl); \
      _Pragma("unroll") for(int r=0;r<16;++r){P0[r]=fsub_s(P0[r],dl);P1[r]=fsub_s(P1[r],dl);} \
      _Pragma("unroll") for(int r=0;r<16;++r)negm[r]=-mhat; asm volatile("":"+v"(negm)); } \
    _Pragma("unroll") for(int r=0;r<16;++r)P0[r]=__builtin_amdgcn_exp2f(P0[r]); }while(0)
  #define RESC() do{ if constexpr(!FIXED) if(resc){ asm volatile("s_waitcnt lgkmcnt(0)":::"memory"); \
      _Pragma("unroll") for(int d_=0;d_<2;++d_) _Pragma("unroll") for(int r=0;r<16;++r)o[d_][r]*=wsf[crow(r,hi)]; } }while(0)
  f32x16 pA0,pA1,pB0,pB1;
  int s_m3=4*SLOTB,s_m1=0,s_p1=2*SLOTB;
  #define ROT1(x) x=((x)==(NSLOT-1)*SLOTB)?0:(x)+SLOTB
  #define ROT() do{ROT1(s_m3);ROT1(s_m1);ROT1(s_p1);}while(0)
  WAIT_BAR(0);
  DMA_K(2,2*SLOTB);DMA_K(3,3*SLOTB);DMA_V(1,SLOTB);DMA_K(4,4*SLOTB);DMA_K(5,5*SLOTB);DMA_V(2,2*SLOTB);DMA_V(3,3*SLOTB);
  qkt(pA0,pA1,Kbase,qr,NEGM,r32,hi);asm volatile("s_nop 15\n\ts_nop 7":"+v"(pA0),"+v"(pA1));CMASK(pA0,pA1,0);
  START(pA0,pA1);
  _Pragma("unroll") for(int r=0;r<16;++r)pA1[r]=__builtin_amdgcn_exp2f(pA1[r]);
  WAIT_BAR(4);
  kload8(kf,kp0+SLOTB);
  WAIT_BAR(4);
  s16x4 vlo[8],vhi[8]; u32x4 pw0,pw1,pw2,pw3; pw3=(u32x4){0u,0u,0u,0u};
  #define PKW(P,B) (FIXED?cvtpk_h(P[B],P[B+1]):cvtpk_s(P[B],P[B+1]))
  #define PVMF(A_,B_,C_) (FIXED?__builtin_amdgcn_mfma_f32_32x32x16_f16(__builtin_bit_cast(h8_t,A_),__builtin_bit_cast(h8_t,B_),C_,0,0,0):__builtin_amdgcn_mfma_f32_32x32x16_bf16(A_,B_,C_,0,0,0))
  #define HSUM(E_) do{ if constexpr(FIXED){ hs=hs+__builtin_bit_cast(h2_t,(unsigned)(E_)); } }while(0)
  #define HSUM2(E_) do{ if constexpr(FIXED){ hs2=hs2+__builtin_bit_cast(h2_t,(unsigned)(E_)); } }while(0)
  #define PAF(k) __builtin_bit_cast(bf16x8,pw##k)
  #define VFR(i) (bf16x8){vlo[i][0],vlo[i][1],vlo[i][2],vlo[i][3],vhi[i][0],vhi[i][1],vhi[i][2],vhi[i][3]}
  #define PIN(x) asm volatile("":"+v"(x))
  #define MX3(a,b,c) __builtin_fmaxf(__builtin_fmaxf((a),(b)),(c))
  #define PINF(PW) do{ if constexpr(FIXED){ PIN(PW); } }while(0)
  #define GAPA(MF,A0,A1,A2,A3,W0,W1,PW,HP,E0,E1,PP) do{ MF; if(HP){ PINF(PP); } if constexpr(!FIXED){ sacc+=A0; sacc+=A1; sacc+=A2; sacc+=A3; PIN(sacc); W0; W1; PIN(PW); } else { if(HP){ HSUM(E0); HSUM2(E1); } W0; W1; if(HP){ PIN(hs); PIN(hs2); } } SBAR(); }while(0)
  #define GAPA0(MF,A0,A1,A2,A3,W0,W1,PW,FL_) do{ MF; if constexpr(!FIXED){ sacc+=A0; sacc+=A1; sacc+=A2; sacc+=A3; PIN(sacc); W0; W1; PIN(PW); } else { PIN(pw3); HSUM(pw3[2]); HSUM2(pw3[3]); \
      if(FL_){ hs=hs+hs2; l_reg=__builtin_amdgcn_fdot2(hs,(h2_t){(_Float16)1.f,(_Float16)1.f},l_reg,false); PIN(l_reg);        hs=(h2_t){(_Float16)0.f,(_Float16)0.f}; hs2=hs; } W0; W1; PIN(hs); PIN(hs2); } SBAR(); }while(0)
  #define EX(v) __builtin_amdgcn_exp2f(v)
  #define GAPB(MF,X,B) do{ MF; X[B]=EX(X[B]); X[B+1]=EX(X[B+1]); X[B+2]=EX(X[B+2]); X[B+3]=EX(X[B+3]); PIN(X); SBAR(); }while(0)
  #define VRD(i) do{ vlo[i]=vtr(vp_+(((i)>>2)*4096+((i)&3)*1024)); vhi[i]=vtr(vp_+(((i)>>2)*4096+((i)&3)*1024+512)); }while(0)
  #define KRD(G,j) do{ if(G){ kload2(kf,kp0+sp1_,j); SBAR(); } }while(0)
  #define STEPS(C0,C1,P0,P1,t,GK,GV,GL,FL,SM1,SM3,SP1) do{ SBAR(); const int sp1_=(SP1); \
    const lds_cptr vp_=vp0+(SM1); \
    VRD(0); SBAR(); float sacc=0.f; if constexpr(!FIXED){ sacc=(P0[0]+P0[1]); } \
    GAPA0(QK0(C0,kf[0],qr[0]), P0[2],P0[3],P0[4],P0[5],     pw0[0]=PKW(P0,0), pw0[1]=PKW(P0,2), pw0, FL); \
    VRD(4); SBAR(); GAPA(QK0(C1,kf[1],qr[0]), P0[6],P0[7],P0[8],P0[9],     pw0[2]=PKW(P0,4), pw0[3]=PKW(P0,6), pw0, true, pw0[0], pw0[1], pw0); \
    VRD(1); SBAR(); GAPA(C0=__builtin_amdgcn_mfma_f32_32x32x16_bf16(kf[2],qr[1],C0,0,0,0),   P0[10],P0[11],P0[12],P0[13], pw1[0]=PKW(P0,8), pw1[1]=PKW(P0,10), pw1, true, pw0[2], pw0[3], pw0); \
    VRD(5); SBAR(); GAPA(C1=__builtin_amdgcn_mfma_f32_32x32x16_bf16(kf[3],qr[1],C1,0,0,0),   P0[14],P0[15],P1[0],P1[1],   pw1[2]=PKW(P0,12), pw1[3]=PKW(P0,14), pw1, true, pw1[0], pw1[1], pw1); \
    VRD(2); SBAR(); GAPA(C0=__builtin_amdgcn_mfma_f32_32x32x16_bf16(kf[4],qr[2],C0,0,0,0),   P1[2],P1[3],P1[4],P1[5],     pw2[0]=PKW(P1,0), pw2[1]=PKW(P1,2), pw2, true, pw1[2], pw1[3], pw1); \
    VRD(6); SBAR(); GAPA(C1=__builtin_amdgcn_mfma_f32_32x32x16_bf16(kf[5],qr[2],C1,0,0,0),   P1[6],P1[7],P1[8],P1[9],     pw2[2]=PKW(P1,4), pw2[3]=PKW(P1,6), pw2, true, pw2[0], pw2[1], pw2); \
    VRD(3); SBAR(); GAPA(C0=__builtin_amdgcn_mfma_f32_32x32x16_bf16(kf[6],qr[3],C0,0,0,0),   P1[10],P1[11],P1[12],P1[13], pw3[0]=PKW(P1,8), pw3[1]=PKW(P1,10), pw3, true, pw2[2], pw2[3], pw2); \
    VRD(7); SBAR(); GAPA(C1=__builtin_amdgcn_mfma_f32_32x32x16_bf16(kf[7],qr[3],C1,0,0,0),   P1[14],P1[15],0.f,0.f,       pw3[2]=PKW(P1,12), pw3[3]=PKW(P1,14), pw3, true, pw3[0], pw3[1], pw3); \
    if constexpr(!FIXED){ l_reg+=sacc; } \
    if(GK){DMA_K((t)+5,(SM1));} if(GV){DMA_V((t)+3,(SM3));} \
    CMASK(C0,C1,t); \
    if constexpr(!FIXED){ float a=MX3(C0[0],C0[1],C1[0]),b=MX3(C0[2],C0[3],C1[1]); a=MX3(a,C1[2],C1[3]); \
      _Pragma("unroll") for(int r=4;r<16;r+=4){a=MX3(a,C0[r],C0[r+1]);b=MX3(b,C0[r+2],C0[r+3]);a=MX3(a,C1[r],C1[r+1]);b=MX3(b,C1[r+2],C1[r+3]);} \
      float rm=__builtin_fmaxf(a,b); { auto rr=__builtin_amdgcn_permlane32_swap(__float_as_uint(rm),__float_as_uint(rm),false,false); rm=__builtin_fmaxf(__uint_as_float(rr[0]),__uint_as_float(rr[1])); } \
      resc=false; \
      if(__builtin_expect(__any(rm>(float)THRL),0)){ const float dl=__builtin_fmaxf(rm,0.f); mhat+=dl; \
        _Pragma("unroll") for(int r=0;r<16;++r){C0[r]-=dl;C1[r]-=dl;} \
        _Pragma("unroll") for(int r=0;r<16;++r)negm[r]=-mhat; asm volatile("":"+v"(negm)); \
        const float f=__builtin_amdgcn_exp2f(-dl); l_reg*=f; if(hi==0)wsf[r32]=f; resc=true; } } \
    SBAR(); \
    GAPB(o[0]=PVMF(PAF(0),VFR(0),o[0]), C0,0); \
    GAPB(o[1]=PVMF(PAF(0),VFR(4),o[1]), C0,4); \
    KRD(GL,0); GAPB(o[0]=PVMF(PAF(1),VFR(1),o[0]), C0,8); \
    KRD(GL,1); GAPB(o[1]=PVMF(PAF(1),VFR(5),o[1]), C0,12); \
    KRD(GL,2); GAPB(o[0]=PVMF(PAF(2),VFR(2),o[0]), C1,0); \
    KRD(GL,3); GAPB(o[1]=PVMF(PAF(2),VFR(6),o[1]), C1,4); \
    GAPB(o[0]=PVMF(PAF(3),VFR(3),o[0]), C1,8); \
    GAPB(o[1]=PVMF(PAF(3),VFR(7),o[1]), C1,12); \
    }while(0)
  #define STEP(C0,C1,P0,P1,t,GK,GV,GL,FL) STEPS(C0,C1,P0,P1,t,GK,GV,GL,FL,s_m1,s_m3,s_p1)
  #define SC(k) ((k)*SLOTB)
  int t=1;
  #undef CMASK
  #define CMASK(P0,P1,t) do{}while(0)
  for(;t+10<NT;t+=6){
    STEPS(pB0,pB1,pA0,pA1,t,  true,true,true,true, SC(0),SC(4),SC(2));   RESC();
    STEPS(pA0,pA1,pB0,pB1,t+1,true,true,true,false,SC(1),SC(5),SC(3));   WAIT_BAR(4); RESC();
    STEPS(pB0,pB1,pA0,pA1,t+2,true,true,true,true, SC(2),SC(0),SC(4));   RESC();
    STEPS(pA0,pA1,pB0,pB1,t+3,true,true,true,false,SC(3),SC(1),SC(5));   WAIT_BAR(4); RESC();
    STEPS(pB0,pB1,pA0,pA1,t+4,true,true,true,true, SC(4),SC(2),SC(0));   RESC();
    STEPS(pA0,pA1,pB0,pB1,t+5,true,true,true,false,SC(5),SC(3),SC(1));   WAIT_BAR(4); RESC();
  }
  for(;t+7<NT;t+=2){
    STEP(pB0,pB1,pA0,pA1,t,true,true,true,true);     RESC(); ROT();
    STEP(pA0,pA1,pB0,pB1,t+1,true,true,true,false);   WAIT_BAR(4); RESC(); ROT();
  }
  #undef CMASK
  #define CMASK(P0,P1,t) do{}while(0)
  #define ENDW(tt) do{ if((tt)+6<NT){WAIT_BAR(4);} else if((tt)+4<NT){WAIT_BAR(2);} else {WAIT_BAR(0);} }while(0)
  for(;t+1<NT;t+=2){
    STEP(pB0,pB1,pA0,pA1,t,(t+5<NT),(t+3<NT),(t+1<NT),true);       RESC(); ROT();
    STEP(pA0,pA1,pB0,pB1,t+1,(t+6<NT),(t+4<NT),(t+2<NT),false);     ENDW(t); RESC(); ROT();
  }
  STEP(pB0,pB1,pA0,pA1,NT-1,false,false,false,true); RESC();
  { if constexpr(!FIXED){ float sacc=pB0[0]+pB0[1]; _Pragma("unroll") for(int r=2;r<16;++r)sacc+=pB0[r]; _Pragma("unroll") for(int r=0;r<16;++r)sacc+=pB1[r]; l_reg+=sacc; }
    if constexpr(FIXED){ HSUM(pw3[2]); HSUM2(pw3[3]); }
    pw0=(u32x4){PKW(pB0,0),PKW(pB0,2),PKW(pB0,4),PKW(pB0,6)};pw1=(u32x4){PKW(pB0,8),PKW(pB0,10),PKW(pB0,12),PKW(pB0,14)};pw2=(u32x4){PKW(pB1,0),PKW(pB1,2),PKW(pB1,4),PKW(pB1,6)};pw3=(u32x4){PKW(pB1,8),PKW(pB1,10),PKW(pB1,12),PKW(pB1,14)};
    if constexpr(FIXED){ _Pragma("unroll") for(int q_=0;q_<4;++q_){ HSUM(pw0[q_]); HSUM2(pw1[q_]); HSUM(pw2[q_]); HSUM2(pw3[q_]); } hs=hs+hs2; l_reg=__builtin_amdgcn_fdot2(hs,(h2_t){(_Float16)1.f,(_Float16)1.f},l_reg,false); }
    const int sl_last=(s_m1==(NSLOT-1)*SLOTB)?0:s_m1+SLOTB;
    SBAR(); if constexpr(FIXED) pvh(o,vb0+sl_last,PAF(0),PAF(1),PAF(2),PAF(3)); else pv(o,vb0+sl_last,PAF(0),PAF(1),PAF(2),PAF(3)); }
  #undef PKW
  #undef PVMF
  #undef HSUM
  #undef HSUM2
  #undef PAF
  #undef VFR
  #undef PIN
  #undef MX3
  #undef GAPA
  #undef GAPA0
  #undef PINF
  #undef GAPB
  #undef EX
  #undef VRD
  #undef KRD
  #undef STEP
  #undef STEPS
  #undef SC
  #undef ENDW
  {auto rr=__builtin_amdgcn_permlane32_swap(__float_as_uint(l_reg),__float_as_uint(l_reg),false,false);l_reg=__uint_as_float(rr[0])+__uint_as_float(rr[1]);}
  if(hi==0)wsf[32+r32]=l_reg;asm volatile("s_waitcnt lgkmcnt(0)":::"memory");
  float rli[16];
  #pragma unroll
  for(int r=0;r<16;++r)rli[r]=__builtin_amdgcn_rcpf(wsf[32+crow(r,hi)]);
  bf16*Ow=Ou+(long)(wid*QBLK)*PO;
  { bf16*stg=(bf16*)(shm+LDS_OST)+wid*2048;
    #pragma unroll
    for(int r=0;r<16;++r){const int orow=crow(r,hi);
      #pragma unroll
      for(int d0=0;d0<2;++d0)stg[orow*64+d0*32+r32]=__float2bfloat16(o[d0][r]*rli[r]);}
    asm volatile("s_waitcnt lgkmcnt(0)":::"memory");
    #pragma unroll
    for(int i=0;i<4;++i){const int row=i*8+(lane>>3),ch=lane&7; const u32x4 v=*(const u32x4*)(stg+row*64+ch*8); ATTN_STORE16(Ow+(long)row*PO+ch*8,v);} }
  asm volatile("s_waitcnt lgkmcnt(0)\n\ts_barrier":::"memory");
  #undef DMA_K
  #undef DMA_V
  #undef CMASK
  #undef START
  #undef NEGM
  #undef QK0
  #undef RESC
  #undef ROT
  #undef ROT1
}

constexpr int SEQ_=16384, INW_=6912, MTOK_=2*SEQ_;
constexpr int B_LDS_K=0, B_LDS_V=49152, B_LDS_WS=98304, B_LDS_BYTES=98304+2048;
__device__ __forceinline__ void attnb_phase(int u0,int ustep,const bf16*P,bf16*Ob,float*Lse,char*shm,unsigned*qhead){
  int tid_=threadIdx.x; asm volatile("":"+v"(tid_));
  const int tid=tid_,lane=tid&63,r32=lane&31,hi=lane>>5; const int wid=__builtin_amdgcn_readfirstlane(tid>>6);
  const unsigned lds0=(unsigned)(uintptr_t)shm;
  float*wsf=(float*)(shm+B_LDS_WS)+wid*64;
  const float C2=0.125f*1.4426950408889634f;
  const int jt0=wid>>1;
  const float ltf=(float)(4*hi-r32-32*(wid&1)-64);
  const int vb0=(int)(lds0+B_LDS_V)+((lane>>4)&1)*32+(lane&3)*8+(4*hi+((lane&15)>>2))*64;
  #define BDEC(u_,b_,g_,h_,dil_,r_,qb_) do{ g_=(u_)>>10; const int rem_=(u_)&1023; b_=rem_>>9; h_=(rem_>>6)&7; const int rq_=rem_&63, dsh_=2*g_; dil_=1<<dsh_; r_=rq_>>(6-dsh_); qb_=rq_&((64>>dsh_)-1); }while(0)
  #define BBASE(kind_,b_,g_,h_,dil_,r_) (P+((size_t)(((((g_)*3+(kind_))*2+(b_))*8+(h_)))<<20)+(size_t)(r_)*(SEQ_/(dil_))*64)
  #define BDMA_K(b_,g_,h_,dil_,r_,qb_) do{ int ln_=lane; asm volatile("":"+v"(ln_)); const int L_=SEQ_/(dil_); const bf16*Pb_=BBASE(1,b_,g_,h_,dil_,r_); const int kb_=(qb_)*256-64; \
      _Pragma("unroll") for(int j=0;j<6;++j){ int ik=kb_+64*j+ln_; ik=ik<0?0:(ik>=L_?L_-1:ik); \
        glds16(Pb_+(size_t)ik*64+wid*8,(unsigned)__builtin_amdgcn_readfirstlane(lds0+B_LDS_K+j*8192+wid*1024)); } }while(0)
  #define BDMA_V(b_,g_,h_,dil_,r_,qb_) do{ int ln_=lane; asm volatile("":"+v"(ln_)); const int L_=SEQ_/(dil_); const bf16*Pb_=BBASE(2,b_,g_,h_,dil_,r_); const int kb_=(qb_)*256-64; \
      _Pragma("unroll") for(int j=0;j<6;++j){ int iv=kb_+64*j+16*(wid&3)+(ln_>>2); iv=iv<0?0:(iv>=L_?L_-1:iv); \
        glds16(Pb_+(size_t)iv*64+(wid>>2)*32+(ln_&3)*8,(unsigned)__builtin_amdgcn_readfirstlane(lds0+B_LDS_V+j*8192+wid*1024)); } }while(0)
  #define BLOAD_Q(Q_,b_,g_,h_,dil_,r_,qb_) do{ int ln_=lane; asm volatile("":"+v"(ln_)); const bf16*qp_=BBASE(0,b_,g_,h_,dil_,r_)+(size_t)((qb_)*256+wid*32+(ln_&31))*64+(ln_>>5)*8; \
      _Pragma("unroll") for(int d0=0;d0<4;++d0)Q_[d0]=*reinterpret_cast<const bf16x8*>(qp_+d0*16); }while(0)
  int u=u0; if(u>=3072)return;
  int*nxw=(int*)(shm+B_LDS_WS);
  if(tid==0){ const unsigned t_=__hip_atomic_fetch_add(qhead,1u,__ATOMIC_RELAXED,__HIP_MEMORY_SCOPE_AGENT); *nxw=ustep+(int)t_; }
  int b,g,h,dil,r,qb; BDEC(u,b,g,h,dil,r,qb);
  bf16x8 qn[4];
  BDMA_K(b,g,h,dil,r,qb); BLOAD_Q(qn,b,g,h,dil,r,qb);
  for(;;){
    asm volatile("":"+v"(qn[0]),"+v"(qn[1]),"+v"(qn[2]),"+v"(qn[3]));
    asm volatile("s_waitcnt vmcnt(0)\n\ts_barrier":::"memory");
    BDMA_V(b,g,h,dil,r,qb);
    const int L=SEQ_/dil, kb_i=qb*256-64, iq=qb*256+wid*32+r32;
    f32x16 s0a,s0b,s1a,s1b,s2a,s2b; const f32x16 zz=f32x16{};
    qkt(s0a,s0b,shm+B_LDS_K+(jt0+0)*8192,qn,zz,r32,hi);
    qkt(s1a,s1b,shm+B_LDS_K+(jt0+1)*8192,qn,zz,r32,hi);
    qkt(s2a,s2b,shm+B_LDS_K+(jt0+2)*8192,qn,zz,r32,hi);
    asm volatile("s_waitcnt lgkmcnt(0)\n\ts_barrier":::"memory");
    const int un=__builtin_amdgcn_readfirstlane(*nxw); const bool has_next=un<3072;
    unsigned tk_=0u; if(tid==0&&has_next){ tk_=__hip_atomic_fetch_add(qhead,1u,__ATOMIC_RELAXED,__HIP_MEMORY_SCOPE_AGENT); }
    int nb=b,ng=g,nh=h,ndil=dil,nr=r,nqb=qb;
    if(has_next){ BDEC(un,nb,ng,nh,ndil,nr,nqb); BDMA_K(nb,ng,nh,ndil,nr,nqb); BLOAD_Q(qn,nb,ng,nh,ndil,nr,nqb); }
    const float slope2=__builtin_ldexpf(1.4426950408889634f*(float)dil,-(h+1));
    float mx=-INFINITY;
    float lt=ltf; asm volatile("":"+v"(lt));
    if(kb_i>=0&&kb_i+384<=L){
      #define BMASKF(S0,S1,tt) do{ _Pragma("unroll") for(int rr=0;rr<16;++rr){ \
          { const float t_=lt+(float)(64*(tt)+(rr&3)+8*(rr>>2)); const float v_=__builtin_fmaf(S0[rr],C2,-slope2*__builtin_fabsf(t_)); S0[rr]=(__builtin_fabsf(t_)<=64.0f)?v_:-INFINITY; mx=__builtin_fmaxf(mx,S0[rr]); } \
          { const float t_=lt+(float)(64*(tt)+(rr&3)+8*(rr>>2)+32); const float v_=__builtin_fmaf(S1[rr],C2,-slope2*__builtin_fabsf(t_)); S1[rr]=(__builtin_fabsf(t_)<=64.0f)?v_:-INFINITY; mx=__builtin_fmaxf(mx,S1[rr]); } } }while(0)
      BMASKF(s0a,s0b,0); BMASKF(s1a,s1b,1); BMASKF(s2a,s2b,2);
      #undef BMASKF
    } else {
      #define BMASK(S0,S1,tt) do{ _Pragma("unroll") for(int rr=0;rr<16;++rr){ const int ik0=kb_i+64*(jt0+(tt))+crow(rr,hi); \
          { const int jj=ik0-iq; const int aj=jj<0?-jj:jj; const bool ok=(aj<=64)&&(ik0>=0)&&(ik0<L); S0[rr]=ok?(S0[rr]*C2-slope2*(float)aj):-INFINITY; mx=__builtin_fmaxf(mx,S0[rr]); } \
          { const int ik1=ik0+32; const int jj=ik1-iq; const int aj=jj<0?-jj:jj; const bool ok=(aj<=64)&&(ik1>=0)&&(ik1<L); S1[rr]=ok?(S1[rr]*C2-slope2*(float)aj):-INFINITY; mx=__builtin_fmaxf(mx,S1[rr]); } } }while(0)
      BMASK(s0a,s0b,0); BMASK(s1a,s1b,1); BMASK(s2a,s2b,2);
      #undef BMASK
    }
    { auto rr=__builtin_amdgcn_permlane32_swap(__float_as_uint(mx),__float_as_uint(mx),false,false); mx=__builtin_fmaxf(__uint_as_float(rr[0]),__uint_as_float(rr[1])); }
    float l=0.f;
    #define BEXP(S) do{ _Pragma("unroll") for(int rr=0;rr<16;++rr){ S[rr]=__builtin_amdgcn_exp2f(S[rr]-mx); l+=S[rr]; } }while(0)
    BEXP(s0a);BEXP(s0b);BEXP(s1a);BEXP(s1b);BEXP(s2a);BEXP(s2b);
    #undef BEXP
    { auto rr=__builtin_amdgcn_permlane32_swap(__float_as_uint(l),__float_as_uint(l),false,false); l=__uint_as_float(rr[0])+__uint_as_float(rr[1]); }
    if(has_next){ asm volatile("s_waitcnt vmcnt(10)\n\ts_barrier":::"memory"); } else { asm volatile("s_waitcnt vmcnt(0)\n\ts_barrier":::"memory"); }
    if(tid==0&&has_next){ *nxw=ustep+(int)tk_; }
    f32x16 o[2]; o[0]=f32x16{}; o[1]=f32x16{};
    #define PKW(P_,B_) cvtpk_s(P_[B_],P_[B_+1])
    #define BPV(SA,SB,tt) do{ u32x4 w0=(u32x4){PKW(SA,0),PKW(SA,2),PKW(SA,4),PKW(SA,6)},w1=(u32x4){PKW(SA,8),PKW(SA,10),PKW(SA,12),PKW(SA,14)},w2=(u32x4){PKW(SB,0),PKW(SB,2),PKW(SB,4),PKW(SB,6)},w3=(u32x4){PKW(SB,8),PKW(SB,10),PKW(SB,12),PKW(SB,14)}; \
        pv(o,vb0+(jt0+(tt))*8192,__builtin_bit_cast(bf16x8,w0),__builtin_bit_cast(bf16x8,w1),__builtin_bit_cast(bf16x8,w2),__builtin_bit_cast(bf16x8,w3)); }while(0)
    BPV(s0a,s0b,0); BPV(s1a,s1b,1); BPV(s2a,s2b,2);
    #undef BPV
    #undef PKW
    { int rl_=r32; asm volatile("":"+v"(rl_)); if(hi==0)wsf[32+rl_]=l; }
    asm volatile("s_waitcnt lgkmcnt(0)\n\ts_barrier":::"memory");
    float rli[16];
    #pragma unroll
    for(int rr=0;rr<16;++rr)rli[rr]=__builtin_amdgcn_rcpf(wsf[32+crow(rr,hi)]);
    const size_t orow0=(size_t)g*MTOK_+(size_t)b*SEQ_;
    { bf16*stg=(bf16*)(shm+B_LDS_V)+wid*2048;
      #pragma unroll
      for(int rr=0;rr<16;++rr){const int orow=crow(rr,hi);
        #pragma unroll
        for(int d0=0;d0<2;++d0)stg[orow*64+d0*32+r32]=__float2bfloat16(o[d0][rr]*rli[rr]);}
      asm volatile("s_waitcnt lgkmcnt(0)":::"memory");
      #pragma unroll
      for(int i=0;i<4;++i){const int row=i*8+(lane>>3),ch=lane&7; const u32x4 v=*(const u32x4*)(stg+row*64+ch*8);
        const int tok=r+dil*(qb*256+wid*32+row); *(u32x4*)(Ob+(orow0+tok)*512+h*64+ch*8)=v;} }
    if(hi==0){ const int tok=r+dil*iq; Lse[(orow0+tok)*8+h]=mx+__builtin_amdgcn_logf(l); }
    asm volatile("s_waitcnt lgkmcnt(0)":::"memory");
    if(!has_next)break;
    u=un; b=nb; g=ng; h=nh; dil=ndil; r=nr; qb=nqb;
  }
  asm volatile("s_waitcnt vmcnt(0) lgkmcnt(0)\n\ts_barrier":::"memory");
  #undef BDEC
  #undef BBASE
  #undef BDMA_K
  #undef BDMA_V
  #undef BLOAD_Q
}
#undef SBAR
#undef WAIT_BAR
}

constexpr int NWAVES = 8;
constexpr int BATCH = 2, SEQ = 16384, DM = 2048, MTOK = BATCH * SEQ;
constexpr int AQW = 1536, AKVW = 384, INW = 6912, BW = 512;
constexpr int NE = 32, TOPK = 4;
constexpr int CAP_ROWS = MTOK * TOPK + NE * 256;
constexpr float NORM_EPS = 1e-5f, QK_EPS = 1e-6f;
constexpr int N_PHASES = 11;

constexpr size_t MiB = 1u << 20;
constexpr size_t WS_CTL = 0, CTL_ZERO_BYTES = 128 * 1024;
constexpr size_t WS_ROPE = 1 * MiB;
constexpr size_t WS_WRT  = 2 * MiB;
constexpr size_t WS_WIN  = 3 * MiB;
constexpr size_t WS_WOUT = 30 * MiB;
constexpr size_t WS_WGU  = 38 * MiB;
constexpr size_t WS_WD   = 550 * MiB;
constexpr size_t WS_HN   = 806 * MiB;
constexpr size_t WS_P    = 934 * MiB;
constexpr size_t WS_QN   = 1366 * MiB;
constexpr size_t WS_KN   = 1462 * MiB;
constexpr size_t WS_OA   = 1486 * MiB;
constexpr size_t WS_OB   = 1582 * MiB;
constexpr size_t WS_LSE  = 1678 * MiB;
constexpr size_t WS_MG   = 1682 * MiB;
constexpr size_t WS_X1   = 1810 * MiB;
constexpr size_t WS_EIDX = 2066 * MiB;
constexpr size_t WS_RANK = 2067 * MiB;
constexpr size_t WS_GATE = 2068 * MiB;
constexpr size_t WS_XG   = 2070 * MiB;
constexpr size_t WS_H    = 2614 * MiB;
constexpr size_t WS_VN   = 3158 * MiB;
constexpr size_t WS_TOKOF = 3182 * MiB;
constexpr size_t WS_END  = 3186 * MiB;
static_assert(WS_XG + (size_t)CAP_ROWS * 2048 * 2 <= WS_H && WS_H + (size_t)CAP_ROWS * 2048 * 2 <= WS_VN, "ws map");
constexpr int CW_TMO = 0, CW_CODE = 1;
constexpr int CW_BAR = 4096;
constexpr int CW_CNT = 16384;
constexpr int CW_Q8 = 16384 + 160, CW_Q9 = 16384 + 192, CW_Q1 = 16384 + 224, CW_Q5 = 16384 + 256;
constexpr int CW_QB = 16384 + 128;
constexpr int CW_VMAX = 16384 + 64;

constexpr int RING_OFF = 0, RING_BYTES = 131072;
constexpr int LDSCTL_OFF = RING_BYTES, MISC_OFF = LDSCTL_OFF + 320;
constexpr int TBL_OFF = 131584;
constexpr int PP_OFF = 134144;
constexpr int QW_OFF = 134304;
constexpr int CNT_OFF = 134400;
constexpr int ROUTE_OFF = 134656;
constexpr int LOGIT_OFF = 138752;
constexpr int LDS_BYTES = 147456;
static_assert(LOGIT_OFF + 32 * 33 * 4 <= LDS_BYTES, "LDS map");

#define GAS __attribute__((address_space(1)))
#define LAS __attribute__((address_space(3)))
typedef unsigned short bf16;
typedef unsigned v4u __attribute__((ext_vector_type(4)));
typedef unsigned v2u __attribute__((ext_vector_type(2)));
typedef float f32x4 __attribute__((ext_vector_type(4)));
typedef float f32x2 __attribute__((ext_vector_type(2)));
typedef float f32x16 __attribute__((ext_vector_type(16)));
typedef short bf16x8 __attribute__((ext_vector_type(8)));
typedef GAS unsigned gu32;
#define RLX_AGENT __ATOMIC_RELAXED, __HIP_MEMORY_SCOPE_AGENT
__device__ __forceinline__ unsigned pk2(float lo, float hi) { typedef __bf16 b2 __attribute__((ext_vector_type(2))); f32x2 v = {lo, hi}; b2 b = __builtin_convertvector(v, b2); return __builtin_bit_cast(unsigned, b); }
__device__ __forceinline__ float bflo(unsigned u) { return __builtin_bit_cast(float, u << 16); }
__device__ __forceinline__ float bfhi(unsigned u) { return __builtin_bit_cast(float, u & 0xffff0000u); }
__device__ __forceinline__ float wave_sum(float v) {
#pragma unroll
    for (int o = 1; o < 64; o <<= 1) v += __shfl_xor(v, o);
    return v;
}

#define XB_TMO      128
#define XB_XCNT(j)  (256  + 64 * (j))
#define XB_XSUB(j)  (1280 + 64 * (j))
#define XB_XGEN(j)  (2304 + 64 * (j))
#define XB_TOP      3328
#define XB_TOPGEN   3392
#define XCD_BAR_WORDS 3456
#define XB_SPIN_CAP (1u << 18)

__device__ __forceinline__ unsigned xb_ld(unsigned* p)              { return __hip_atomic_load(p, __ATOMIC_RELAXED, __HIP_MEMORY_SCOPE_AGENT); }
__device__ __forceinline__ unsigned xb_add(unsigned* p, unsigned v) { return __hip_atomic_fetch_add(p, v, __ATOMIC_RELAXED, __HIP_MEMORY_SCOPE_AGENT); }
__device__ __forceinline__ unsigned xb_xcc_id() { return (unsigned)__builtin_amdgcn_s_getreg((3 << 11) | 20) & 0xFu; }
#define XB_SPIN(cond, bar) do { unsigned _sp = 0; while (cond) { __builtin_amdgcn_s_sleep(1); \
    if ((++_sp & 255u) == 0u) { if (xb_ld(&(bar)[XB_TMO])) break; if (_sp > XB_SPIN_CAP) { atomicAdd(&(bar)[XB_TMO], 1u); break; } } } } while (0)

struct XcdBarrier {
    unsigned* bar; unsigned x;
    volatile LAS unsigned* st;
};

__device__ __forceinline__ XcdBarrier xcd_barrier_post(unsigned* bar, volatile LAS unsigned* st) {
    XcdBarrier b; b.bar = bar; b.x = xb_xcc_id(); b.st = st;
    if (threadIdx.x == 0) (void)xb_add(&bar[XB_XCNT(b.x)], 1u);
    return b;
}
__device__ __forceinline__ void xcd_barrier_complete(unsigned* bar, unsigned x, unsigned& nloc, unsigned& nx) {
    const unsigned G = gridDim.x * gridDim.y * gridDim.z;
    unsigned sum, cnt, mine, sp = 0u;
    for (;;) {
        sum = 0u; cnt = 0u; mine = 0u;
#pragma unroll
        for (unsigned j = 0; j < 16; ++j) { const unsigned c = xb_ld(&bar[XB_XCNT(j)]); sum += c; cnt += (c > 0u) ? 1u : 0u; mine = (j == x) ? c : mine; }
        if (sum == G) break;
        __builtin_amdgcn_s_sleep(1);
        if ((++sp & 255u) == 0u) { if (xb_ld(&bar[XB_TMO])) break; if (sp > XB_SPIN_CAP) { atomicAdd(&bar[XB_TMO], 1u); break; } }
    }
    nloc = mine > 0u ? mine : 1u; nx = cnt > 0u ? cnt : 1u;
}

__device__ __forceinline__ void xcd_barrier(const XcdBarrier& b) {
    asm volatile("s_waitcnt vmcnt(0)" ::: "memory");
    __syncthreads();
    if (threadIdx.x == 0) {
        unsigned* bar = b.bar;
        __builtin_amdgcn_s_waitcnt(0);
        unsigned nloc = b.st[0], nx = b.st[1];
        if (nloc == 0u) { xcd_barrier_complete(bar, b.x, nloc, nx); b.st[0] = nloc; b.st[1] = nx; }
        const unsigned old = xb_add(&bar[XB_XSUB(b.x)], 1u);
        const unsigned gen = old / nloc;
        if (old + 1u == (gen + 1u) * nloc) {
            __builtin_amdgcn_fence(__ATOMIC_RELEASE, "agent");
            asm volatile("s_waitcnt vmcnt(0)" ::: "memory");
            const unsigned og = xb_add(&bar[XB_TOP], 1u);
            const unsigned tg = og / nx;
            if (og + 1u == (tg + 1u) * nx) xb_add(&bar[XB_TOPGEN], 1u);
            else XB_SPIN(xb_ld(&bar[XB_TOPGEN]) == tg, bar);
            __builtin_amdgcn_fence(__ATOMIC_ACQUIRE, "agent");
            xb_add(&bar[XB_XGEN(b.x)], 1u);
            asm volatile("s_waitcnt vmcnt(0)" ::: "memory");
        } else {
            XB_SPIN(xb_ld(&bar[XB_XGEN(b.x)]) == gen, bar);
            __builtin_amdgcn_fence(__ATOMIC_ACQUIRE, "agent");
            asm volatile("s_waitcnt vmcnt(0)" ::: "memory");
        }
    }
    __syncthreads();
}

namespace pg8 {
struct EpiInProjA {
    static constexpr bool PERM = true, AFTER_DRAIN = false, BIAS_DMA = false;
    unsigned char* ws; const float* qnw; const float* knw; const PG8_LAS float* ropeC;
    __device__ __forceinline__ void operator()(const f32x4 (&acc)[2][2][4][2], const Unit& u, int wr, int wc, int fr_in, int fq_in) const {
        int fr = fr_in, fq = fq_in; asm volatile("" : "+v"(fr), "+v"(fq));
        bf16_t* Qn = (bf16_t*)(ws + WS_QN); bf16_t* Kn = (bf16_t*)(ws + WS_KN); unsigned short* Vh = (unsigned short*)(ws + WS_VN); bf16_t* Pv = (bf16_t*)(ws + WS_P);
        const float* rope = (const float*)(ws + WS_ROPE); unsigned* vmax = (unsigned*)(ws + WS_CTL) + CW_VMAX;
        typedef _Float16 h2e __attribute__((ext_vector_type(2))); typedef float f2e __attribute__((ext_vector_type(2)));
        const int hg = 4 * u.pn + wc;
        const int row0 = u.pm * BM + wr * 64 + fr, sb = (u.pm * BM) & 16383;
        if (hg >= 30) {
            unsigned vm = 0u;
#pragma unroll
            for (int ai = 0; ai < 2; ++ai)
#pragma unroll
                for (int m = 0; m < 4; ++m) { const size_t row = (size_t)(row0 + ai * HALF + m * 16);
#pragma unroll
                    for (int bj = 0; bj < 2; ++bj) { const f32x4 v0 = acc[ai][bj][m][0], v1 = acc[ai][bj][m][1]; const int d = 32 * bj + 8 * fq;
                        u32x4 w; w.x = cvt_pk_bf16(v0[0], v0[1]); w.y = cvt_pk_bf16(v0[2], v0[3]); w.z = cvt_pk_bf16(v1[0], v1[1]); w.w = cvt_pk_bf16(v1[2], v1[3]);
                        *(u32x4*)(Pv + row * 2304 + hg * 64 + d) = w;
                        const unsigned ww[4] = {w.x, w.y, w.z, w.w};
#pragma unroll
                        for (int i = 0; i < 4; ++i) { const unsigned lo = ww[i] & 0x7fffu, hi = (ww[i] >> 16) & 0x7fffu; vm = vm > lo ? vm : lo; vm = vm > hi ? vm : hi; }
                        u32x4 h; { f2e t = {v0[0], v0[1]}; h.x = __builtin_bit_cast(unsigned, __builtin_convertvector(t, h2e)); } { f2e t = {v0[2], v0[3]}; h.y = __builtin_bit_cast(unsigned, __builtin_convertvector(t, h2e)); }
                        { f2e t = {v1[0], v1[1]}; h.z = __builtin_bit_cast(unsigned, __builtin_convertvector(t, h2e)); } { f2e t = {v1[2], v1[3]}; h.w = __builtin_bit_cast(unsigned, __builtin_convertvector(t, h2e)); }
                        *(u32x4*)(Vh + row * 384 + (hg - 30) * 64 + d) = h; } }
#pragma unroll
            for (int o = 1; o < 64; o <<= 1) { const unsigned t = (unsigned)__shfl_xor((int)vm, o); vm = vm > t ? vm : t; }
            if ((fr | fq) == 0) atomicMax(vmax, vm);
        } else {
            const bool isq = hg < 24; const float* nw = isq ? qnw : knw; const float sc = isq ? 0.125f * 1.4426950408889634f : 1.0f;
            const bool isx1 = fq < 2; const int i16b = 8 * (fq & 1);
            f32x4 wv[2][2];
#pragma unroll
            for (int bj = 0; bj < 2; ++bj)
#pragma unroll
                for (int n = 0; n < 2; ++n) wv[bj][n] = *(const f32x4*)(nw + 32 * bj + 8 * fq + 4 * n);
            bf16_t* obase = isq ? (Qn + hg * 64) : (Kn + (hg - 24) * 64); const int opitch = isq ? 1536 : 384;
#pragma unroll
            for (int ai = 0; ai < 2; ++ai) {
                const int pos_r = (sb + ai * HALF + wr * 64) >> 6;
                f32x4 er[4];
#pragma unroll
                for (int q = 0; q < 4; ++q) er[q] = *(const f32x4*)(rope + 2 * (pos_r * 16 + i16b) + 4 * q);
#pragma unroll
                for (int m = 0; m < 4; ++m) {
                    const int pos_c = 16 * m + fr; f32x4 ec[4];
#pragma unroll
                    for (int q = 0; q < 4; ++q) ec[q] = *(const PG8_LAS f32x4*)(ropeC + 2 * (pos_c * 16 + i16b) + 4 * q);
                    float ss = 0.f;
#pragma unroll
                    for (int bj = 0; bj < 2; ++bj)
#pragma unroll
                        for (int n = 0; n < 2; ++n) { const f32x4 x = acc[ai][bj][m][n]; ss += (x[0] * x[0] + x[1] * x[1]) + (x[2] * x[2] + x[3] * x[3]); }
                    { auto r16 = __builtin_amdgcn_permlane16_swap(__float_as_uint(ss), __float_as_uint(ss), false, false); ss = __uint_as_float(r16[0]) + __uint_as_float(r16[1]); }
                    { auto r32 = __builtin_amdgcn_permlane32_swap(__float_as_uint(ss), __float_as_uint(ss), false, false); ss = __uint_as_float(r32[0]) + __uint_as_float(r32[1]); }
                    const float rstd = __builtin_amdgcn_rsqf(ss * (1.f / 64.f) + 1e-6f);
                    const size_t row = (size_t)(row0 + ai * HALF + m * 16);
#pragma unroll
                    for (int bj = 0; bj < 2; ++bj) { float ov[8];
#pragma unroll
                        for (int n = 0; n < 2; ++n)
#pragma unroll
                            for (int j = 0; j < 4; ++j) { const int e = 4 * n + j; const f32x4 E = bj ? ec[e >> 1] : er[e >> 1];
                                const float c = (e & 1) ? E[2] : E[0], sn = (e & 1) ? E[3] : E[1];
                                const float y = acc[ai][bj][m][n][j] * rstd * wv[bj][n][j]; float py; { auto r32 = __builtin_amdgcn_permlane32_swap(__float_as_uint(y), __float_as_uint(y), false, false); py = __uint_as_float(fq < 2 ? r32[1] : r32[0]); }
                                ov[e] = (isx1 ? (y * c - py * sn) : (y * c + py * sn)) * sc; }
                        u32x4 w; w.x = cvt_pk_bf16(ov[0], ov[1]); w.y = cvt_pk_bf16(ov[2], ov[3]); w.z = cvt_pk_bf16(ov[4], ov[5]); w.w = cvt_pk_bf16(ov[6], ov[7]);
                        *(u32x4*)(obase + row * opitch + 32 * bj + 8 * fq) = w; }
                }
            }
        }
    }
};
}

template <int REMAP>
__device__ __forceinline__ void transpose_item(const float* __restrict__ W, int N, bf16* __restrict__ WT, int k0, int n0, int lane) {
    const int n = n0 + 4 * lane;
    int drow = n;
    if (REMAP == 1) { const int isup = n >= 2048; const int s = isup ? n - 2048 : n; drow = 256 * (s >> 7) + (isup ? 128 : 0) + (s & 127); }
    if (REMAP == 2) { const int c = n & 255; drow = (n & ~255) + 128 * ((c & 63) >> 5) + 32 * (c >> 6) + (c & 31); }
#pragma unroll 2
    for (int kc = 0; kc < 8; ++kc) {
        const int k = k0 + 8 * kc;
        f32x4 v[8];
#pragma unroll
        for (int i = 0; i < 8; ++i) v[i] = __builtin_nontemporal_load((const f32x4*)(W + (size_t)(k + i) * N + n));
        __builtin_amdgcn_sched_barrier(0);
#pragma unroll
        for (int j = 0; j < 4; ++j) { v4u o; o.x = pk2(v[0][j], v[1][j]); o.y = pk2(v[2][j], v[3][j]); o.z = pk2(v[4][j], v[5][j]); o.w = pk2(v[6][j], v[7][j]);
            *(v4u*)(WT + (size_t)(drow + j) * 2048 + k) = o; }
    }
}
template <int REMAP>
__device__ __forceinline__ void transpose_item_f8(const float* __restrict__ W, int N, unsigned char* __restrict__ WT, int k0, int n0, int lane, float sc) {
    const int n = n0 + 4 * lane;
    int drow = n;
    if (REMAP == 1) { const int isup = n >= 2048; const int s = isup ? n - 2048 : n; drow = 256 * (s >> 7) + (isup ? 128 : 0) + (s & 127); }
#pragma unroll 1
    for (int kc = 0; kc < 4; ++kc) {
        const int k = k0 + 16 * kc;
        f32x4 v[16];
#pragma unroll
        for (int i = 0; i < 16; ++i) v[i] = __builtin_nontemporal_load((const f32x4*)(W + (size_t)(k + i) * N + n));
        __builtin_amdgcn_sched_barrier(0);
#pragma unroll
        for (int i = 0; i < 16; ++i) v[i] = v[i] * sc;
#pragma unroll
        for (int j = 0; j < 4; ++j) { v4u o; o.x = pg8::pk4_fp8(v[0][j], v[1][j], v[2][j], v[3][j]); o.y = pg8::pk4_fp8(v[4][j], v[5][j], v[6][j], v[7][j]);
            o.z = pg8::pk4_fp8(v[8][j], v[9][j], v[10][j], v[11][j]); o.w = pg8::pk4_fp8(v[12][j], v[13][j], v[14][j], v[15][j]);
            *(v4u*)(WT + (size_t)(drow + j) * 2048 + k) = o; }
    }
}
__device__ __forceinline__ void rms_row_to_bf16(const float* __restrict__ xrow, const f32x4 (&wv)[8], bf16* __restrict__ orow, unsigned char* __restrict__ orow8, int lane) {
    const f32x4* xr = (const f32x4*)xrow + lane;
    f32x4 v[8]; float ss = 0.f;
#pragma unroll
    for (int j = 0; j < 8; ++j) v[j] = xr[64 * j];
    __builtin_amdgcn_sched_barrier(0);
#pragma unroll
    for (int j = 0; j < 8; ++j) ss += (v[j].x * v[j].x + v[j].y * v[j].y) + (v[j].z * v[j].z + v[j].w * v[j].w);
    const float rstd = rsqrtf(wave_sum(ss) * (1.f / 2048.f) + NORM_EPS);
    v2u* o8 = (v2u*)orow + lane;
#pragma unroll
    for (int j = 0; j < 8; ++j) { const f32x4 ww = wv[j]; const float h0 = v[j].x * rstd * ww.x, h1 = v[j].y * rstd * ww.y, h2 = v[j].z * rstd * ww.z, h3 = v[j].w * rstd * ww.w;
        v2u o; o.x = pk2(h0, h1); o.y = pk2(h2, h3); o8[64 * j] = o; ((unsigned*)orow8)[lane + 64 * j] = pg8::pk4_fp8(h0, h1, h2, h3); }
}
__device__ __forceinline__ void moe_weight_convert_blk(const float* __restrict__ w_gate_up, const float* __restrict__ w_down, unsigned char* __restrict__ Wgu8, unsigned char* __restrict__ Wd8,
                                                       unsigned char* ldsb, int blk, int nblk, int wave, int lane, float sc) {
    constexpr int I_GU = 8 * 16, I_D = 8 * 8, NIT = NE * (I_GU + I_D);
    asm volatile("" : "+v"(lane));
    f32x4 v[32];
#define MWC_DECODE(it_, src_, N_, dst_, k0_, n0_, gu_) do { if ((it_) < NE * I_GU) { const int e_ = (it_) / I_GU, q_ = (it_) % I_GU; src_ = w_gate_up + (size_t)e_ * 2048 * 4096; N_ = 4096; dst_ = Wgu8 + (size_t)e_ * 4096 * 2048; k0_ = 256 * (q_ / 16); n0_ = 256 * (q_ % 16); gu_ = 1; } \
        else { const int r_ = (it_) - NE * I_GU, e_ = r_ / I_D, q_ = r_ % I_D; src_ = w_down + (size_t)e_ * 2048 * 2048; N_ = 2048; dst_ = Wd8 + (size_t)e_ * 2048 * 2048; k0_ = 256 * (q_ / 8); n0_ = 256 * (q_ % 8); gu_ = 0; } } while (0)
#define MWC_LOAD(src_, N_, k0_, n0_) do { const float* p_ = (src_) + (size_t)((k0_) + 32 * wave) * (N_) + (n0_) + 4 * lane; _Pragma("unroll") for (int r_ = 0; r_ < 32; ++r_) v[r_] = __builtin_nontemporal_load((const f32x4*)(p_ + (size_t)r_ * (N_))); } while (0)
    int it = blk, buf = 0;
    const float* src = w_gate_up; unsigned char* dst = Wgu8; int N = 4096, k0 = 0, n0 = 0, gu = 1;
    if (it < NIT) { MWC_DECODE(it, src, N, dst, k0, n0, gu); MWC_LOAD(src, N, k0, n0); }
    for (; it < NIT; it += nblk) {
        __builtin_amdgcn_sched_barrier(0);
        unsigned char* img = ldsb + buf * 65536;
#pragma unroll
        for (int j = 0; j < 4; ++j) {
#pragma unroll
            for (int hh = 0; hh < 2; ++hh) { v4u o; o.x = pg8::pk4_fp8(v[16 * hh + 0][j] * sc, v[16 * hh + 1][j] * sc, v[16 * hh + 2][j] * sc, v[16 * hh + 3][j] * sc); o.y = pg8::pk4_fp8(v[16 * hh + 4][j] * sc, v[16 * hh + 5][j] * sc, v[16 * hh + 6][j] * sc, v[16 * hh + 7][j] * sc);
                o.z = pg8::pk4_fp8(v[16 * hh + 8][j] * sc, v[16 * hh + 9][j] * sc, v[16 * hh + 10][j] * sc, v[16 * hh + 11][j] * sc); o.w = pg8::pk4_fp8(v[16 * hh + 12][j] * sc, v[16 * hh + 13][j] * sc, v[16 * hh + 14][j] * sc, v[16 * hh + 15][j] * sc);
                *(v4u*)(img + (4 * lane + j) * 256 + 16 * ((2 * wave + hh) ^ (lane & 7))) = o; } }
        asm volatile("s_waitcnt lgkmcnt(0)" ::: "memory"); __builtin_amdgcn_s_barrier();
        __builtin_amdgcn_sched_barrier(0);
        const int nxt = it + nblk; const unsigned char* cdst = dst; const int ck0 = k0, cn0 = n0, cgu = gu;
        if (nxt < NIT) { MWC_DECODE(nxt, src, N, dst, k0, n0, gu); MWC_LOAD(src, N, k0, n0); }
        __builtin_amdgcn_sched_barrier(0);
#pragma unroll
        for (int qq = 0; qq < 2; ++qq) {
            v4u dd[4];
#pragma unroll
            for (int q = 0; q < 4; ++q) { const int n = 32 * wave + 16 * qq + 4 * q + (lane >> 4), c = lane & 15; dd[q] = *(const v4u*)(img + n * 256 + 16 * (c ^ ((n >> 2) & 7))); }
            __builtin_amdgcn_sched_barrier(0);
#pragma unroll
            for (int q = 0; q < 4; ++q) { const int n = 32 * wave + 16 * qq + 4 * q + (lane >> 4), c = lane & 15;
                const int ng = cn0 + n; int drow = ng;
                if (cgu) { const int isup = cn0 >= 2048; const int s = isup ? ng - 2048 : ng; drow = 256 * (s >> 7) + (isup ? 128 : 0) + (s & 127); }
                *(v4u*)((unsigned char*)cdst + (size_t)drow * 2048 + ck0 + 16 * c) = dd[q]; }
        }
        buf ^= 1;
    }
    asm volatile("s_waitcnt vmcnt(0) lgkmcnt(0)" ::: "memory"); __builtin_amdgcn_s_barrier();
#undef MWC_DECODE
#undef MWC_LOAD
}
__device__ __forceinline__ v4u bf8_to_h8(v4u r) {
    typedef _Float16 h2v __attribute__((ext_vector_type(2)));
    v4u o;
    { f32x2 t = {bflo(r.x), bfhi(r.x)}; o.x = __builtin_bit_cast(unsigned, __builtin_convertvector(t, h2v)); }
    { f32x2 t = {bflo(r.y), bfhi(r.y)}; o.y = __builtin_bit_cast(unsigned, __builtin_convertvector(t, h2v)); }
    { f32x2 t = {bflo(r.z), bfhi(r.z)}; o.z = __builtin_bit_cast(unsigned, __builtin_convertvector(t, h2v)); }
    { f32x2 t = {bflo(r.w), bfhi(r.w)}; o.w = __builtin_bit_cast(unsigned, __builtin_convertvector(t, h2v)); }
    return o;
}
__device__ __forceinline__ unsigned umax4(unsigned m, v4u r) {
    const unsigned w[4] = {r.x, r.y, r.z, r.w};
#pragma unroll
    for (int i = 0; i < 4; ++i) { const unsigned lo = w[i] & 0x7fffu, hi = (w[i] >> 16) & 0x7fffu; m = m > lo ? m : lo; m = m > hi ? m : hi; }
    return m;
}
__device__ __forceinline__ void moe_tables(unsigned* gcnt, int* tile_e, int* ppad, int* ecnt, int tid) {
    __syncthreads();
    if (tid == 0) { int acc = 0;
        for (int e = 0; e < NE; ++e) { const int c = (int)__hip_atomic_load(gcnt + e, RLX_AGENT); const int nt = (c + 255) >> 8; ppad[e] = acc * 256; ecnt[e] = c; for (int t = 0; t < nt; ++t) tile_e[acc + t] = e; acc += nt; }
        ppad[32] = acc * 256; ppad[33] = acc; }
    __syncthreads();
}

struct Args { const float* in[15]; float* out; unsigned char* ws; int ph_lo, ph_hi; };
__global__ void __launch_bounds__(NWAVES * 64, 2) mk_fwd(Args args) {
    extern __shared__ __attribute__((aligned(16))) unsigned char lds[];
    const int tid = threadIdx.x, lane = tid & 63, wave = __builtin_amdgcn_readfirstlane(tid >> 6);
    const int G = gridDim.x, bx = blockIdx.x;
    const int nx = (G % 8 == 0) ? 8 : 1, gx = G / nx;
    const int vcu = (bx % nx) * gx + bx / nx;
    const int gw = vcu * NWAVES + wave, NGW = G * NWAVES;
    unsigned char* ws = args.ws;
    unsigned* ctl = (unsigned*)(ws + WS_CTL);
    const float* x = args.in[0]; const float* norm_mix_w = args.in[1]; const float* w_in = args.in[2]; const float* q_norm_w = args.in[3]; const float* k_norm_w = args.in[4];
    const float* out_norm_w = args.in[5]; const float* w_out = args.in[6]; const float* norm_moe_w = args.in[7]; const float* w_router = args.in[8]; const float* b_router = args.in[9];
    const float* w_gate_up = args.in[10]; const float* b_gate_up = args.in[11]; const float* w_down = args.in[12]; const float* b_down = args.in[13]; const float* final_norm_w = args.in[14];
    float* out = args.out;
    f32x2* rope = (f32x2*)(ws + WS_ROPE);
    bf16* WrT = (bf16*)(ws + WS_WRT); bf16* WinT = (bf16*)(ws + WS_WIN); bf16* WoutT = (bf16*)(ws + WS_WOUT); unsigned char* Wgu8 = ws + WS_WGU; unsigned char* Wd8 = ws + WS_WD;
    bf16* Hn = (bf16*)(ws + WS_HN); bf16* P = (bf16*)(ws + WS_P); bf16* PB = (bf16*)(ws + WS_P + 144 * MiB); bf16* Qn = (bf16*)(ws + WS_QN); bf16* Kn = (bf16*)(ws + WS_KN); bf16* Vn = (bf16*)(ws + WS_VN); bf16* Oa = (bf16*)(ws + WS_OA);
    bf16* Ob = (bf16*)(ws + WS_OB); float* Lse = (float*)(ws + WS_LSE); bf16* Mg = (bf16*)(ws + WS_MG); bf16* X1 = (bf16*)(ws + WS_X1);
    int* Eidx = (int*)(ws + WS_EIDX); int* Rank = (int*)(ws + WS_RANK); float* Gate = (float*)(ws + WS_GATE);
    unsigned char* Y8 = ws + WS_XG; unsigned char* Hact8 = ws + WS_H + 272 * MiB; unsigned char* Hnx8 = ws + WS_H;
    unsigned char* Win8 = ws + WS_WIN + 9 * MiB;                    unsigned char* Hn8 = ws + WS_HN;
    constexpr float WSC = 32.0f, WSC_INV = 1.0f / 32.0f;
    unsigned* gcnt = ctl + CW_CNT;
    int* tile_e = (int*)(lds + TBL_OFF); int* ppad = (int*)(lds + PP_OFF); int* ecnt = (int*)(lds + CNT_OFF); int* tokbuf = (int*)(lds + ROUTE_OFF);
    int* TokOf = (int*)(ws + WS_TOKOF);

    for (int u = tid; u < (LDS_BYTES - LDSCTL_OFF) / 4; u += NWAVES * 64) ((unsigned*)(lds + LDSCTL_OFF))[u] = 0u;
    __syncthreads();
#if MK_SPLIT
#define GRID_BAR() do { } while (0)
#define GRID_BAR_F() (void)0
#else
    XcdBarrier bar = xcd_barrier_post(ctl + CW_BAR, (volatile LAS unsigned*)(lds + MISC_OFF) + 8);
#define GRID_BAR() xcd_barrier(bar)
#define GRID_BAR_F() xcd_barrier(bar)
#endif
    const int lo = args.ph_lo, hi_ph = args.ph_hi;
#define IN(k) (lo <= (k) && (k) < hi_ph)
#ifndef PROBE_MASK
#define PROBE_MASK 0
#endif
#define PHASE_REP(k) _Pragma("unroll") for (int rep_ = 0; rep_ <= ((PROBE_MASK >> (k)) & 1); ++rep_) if (rep_ > 0 && (GRID_BAR_F(), false)) {} else
#define PHASE_LANE() int lane_l_ = (int)__builtin_amdgcn_mbcnt_hi(~0u, __builtin_amdgcn_mbcnt_lo(~0u, 0u)); asm volatile("" : "+v"(lane_l_)); const int lane = lane_l_, tid = wave * 64 + lane_l_; (void)tid
#define BOTH(k) (IN(k) && IN((k) + 1))

    if (IN(0)) { PHASE_REP(0) {
        PHASE_LANE();
        constexpr int I_IN = 32 * 27, I_OUT = 32 * 8;
        constexpr int NITEMS = I_IN + I_OUT;
        for (int it = gw; it < NITEMS; it += NGW) {
            int r = it;
            if (r < I_IN) { const int nb = r % 27; if (nb < 9) transpose_item<2>(w_in, INW, WinT, 64 * (r / 27), 256 * nb, lane); else transpose_item_f8<0>(w_in, INW, Win8 - (size_t)2304 * 2048, 64 * (r / 27), 256 * nb, lane, WSC); continue; } r -= I_IN;
            transpose_item<0>(w_out, DM, WoutT, 64 * (r / 8), 256 * (r % 8), lane);
        }
        const int gt = gw * 64 + lane;
        if (gt < 8192) { const int n = gt & 31, kc = gt >> 5; float v[8];
#pragma unroll
            for (int i = 0; i < 8; ++i) v[i] = w_router[(size_t)(8 * kc + i) * NE + n];
            v4u o; o.x = pk2(v[0], v[1]); o.y = pk2(v[2], v[3]); o.z = pk2(v[4], v[5]); o.w = pk2(v[6], v[7]);
            *(v4u*)(WrT + (size_t)n * 2048 + 8 * kc) = o; }
        if (gt >= 8192 && gt < 8192 + 4096) { const int id = gt - 8192, pos = id >> 4, i = id & 15;
            double th = 1.0; for (int q = 0; q < i; ++q) th *= 0.56234132519034908;
            double c = 1.0, s = th, tc = 1.0, tsn = th; const double t2 = th * th;
            for (int n = 1; n <= 11; ++n) { tc *= -t2 / (double)((2 * n - 1) * (2 * n)); c += tc; tsn *= -t2 / (double)((2 * n) * (2 * n + 1)); s += tsn; }
            double rc = 1.0, rs = 0.0, bc = c, bs = s;
            for (int bit = 0; bit < 9; ++bit) { if ((pos >> bit) & 1) { const double t = rc * bc - rs * bs; rs = rc * bs + rs * bc; rc = t; } const double t = bc * bc - bs * bs; bs = 2.0 * bc * bs; bc = t; }
            f32x2 cs; cs.x = (float)rc; cs.y = (float)rs; rope[id] = cs; }
        { f32x4 wv[8];
#pragma unroll
          for (int j = 0; j < 8; ++j) wv[j] = ((const f32x4*)norm_mix_w)[lane + 64 * j];
          for (int m = gw; m < MTOK; m += NGW) rms_row_to_bf16(x + (size_t)m * DM, wv, Hn + (size_t)m * DM, Hnx8 + (size_t)m * DM, lane); }
        }
        if (BOTH(0)) GRID_BAR();
    }

    if (IN(1)) { PHASE_REP(1) {
        PHASE_LANE();
        {
            float* ropeC = (float*)(lds + ROUTE_OFF);
            for (int i = tid; i < 2048; i += NWAVES * 64) ropeC[i] = ((const float*)rope)[i];
            __syncthreads();
            pg8::StaticOrder S; S.init(MTOK / 256, 9, G, bx);
            pg8::EpiInProjA E{ws, q_norm_w, k_norm_w, (const PG8_LAS float*)ropeC};
            pg8::gemm_phase<pg8::EpiInProjA, pg8::StaticOrder, true, true>((PG8_LAS unsigned char*)lds + RING_OFF, DM, (const char*)Hn, (const char*)WinT, S, E);
        }
        {
            pg8::BalancedOrder S; S.init(MTOK / 256, 18, G, bx, ((MTOK / 256) * 9) % G, 2, 1);
            pg8::EpiInProj E{P, PB, 9, WSC_INV};
            pg8::gemm_phase<pg8::EpiInProj, pg8::BalancedOrder, true, true, true>((PG8_LAS unsigned char*)lds + RING_OFF, DM / 2, (const char*)Hnx8, (const char*)Win8, S, E);
        }
        }
        if (BOTH(1)) GRID_BAR();
    }


    if (IN(3)) { PHASE_REP(3) {
        PHASE_LANE();
        bool conv_done = false;
        {
            const int per = 3072 / nx, xcd = vcu / gx, vi = vcu % gx;
            float mq = 0.f, mk = 0.f;
            for (int i = 0; i < 64; ++i) { mq = fmaxf(mq, fabsf(q_norm_w[i])); mk = fmaxf(mk, fabsf(k_norm_w[i])); }
            const float b2 = 8.0f * 1.4426950408889634f * mq * mk;
            const float vmaxf = __uint_as_float(__hip_atomic_load(ctl + CW_VMAX, RLX_AGENT) << 16);
            const bool fixed_ref = b2 <= 14.0f && vmaxf < 6.0e4f;
            const float mref = fmaxf(b2 - 9.0f, 0.0f);
            const int rounds = (per + gx - 1) / gx, cslot = vcu % rounds; int ri = 0;
            for (int li = vi; li < per; li += gx, ++ri) {
                if (ri == cslot) { moe_weight_convert_blk(w_gate_up, w_down, Wgu8, Wd8, lds + RING_OFF, vcu, G, wave, lane, WSC); conv_done = true; }
                const int u = xcd * per + li;
                const int qb = u & 63, g4 = (u >> 6) & 3, kvh = (u >> 8) % 6, b = u / 1536, qh = kvh * 4 + g4;
                const size_t qoff = ((size_t)b * SEQ + (size_t)qb * 256) * AQW + qh * 64;
                const attn_body::bf16* kp = (const attn_body::bf16*)Kn + (size_t)b * SEQ * AKVW + kvh * 64; const attn_body::bf16* vp = (const attn_body::bf16*)Vn + (size_t)b * SEQ * AKVW + kvh * 64; const attn_body::bf16* vraw = (const attn_body::bf16*)P + (size_t)b * SEQ * 2304 + (AQW + AKVW) + kvh * 64;
                if (fixed_ref) attn_body::attn_unit<true, 8, AQW, AKVW, AKVW, AQW, SEQ / 64>((const attn_body::bf16*)Qn + qoff, kp, vp, (attn_body::bf16*)Oa + qoff, (char*)lds + RING_OFF, mref);
                else attn_body::attn_unit<false, 8, AQW, AKVW, 2304, AQW, SEQ / 64>((const attn_body::bf16*)Qn + qoff, kp, vraw, (attn_body::bf16*)Oa + qoff, (char*)lds + RING_OFF, 0.f);
            }
        }
        if (!conv_done) moe_weight_convert_blk(w_gate_up, w_down, Wgu8, Wd8, lds + RING_OFF, vcu, G, wave, lane, WSC);
        {
            attn_body::attnb_phase(vcu, G, (const attn_body::bf16*)PB, (attn_body::bf16*)Ob, Lse, (char*)lds + RING_OFF, ctl + CW_QB);
        }
        }
        if (BOTH(3)) GRID_BAR();
    }

    if (IN(4)) { PHASE_REP(4) {
        PHASE_LANE();
        f32x4 onw[8];
#pragma unroll
        for (int j = 0; j < 3; ++j) { onw[2 * j] = *(const f32x4*)(out_norm_w + 8 * (lane + 64 * j)); onw[2 * j + 1] = *(const f32x4*)(out_norm_w + 8 * (lane + 64 * j) + 4); }
        onw[6] = *(const f32x4*)(out_norm_w + AQW + 8 * lane); onw[7] = *(const f32x4*)(out_norm_w + AQW + 8 * lane + 4);
        for (int row = gw; row < MTOK; row += NGW) {
            float oa[24]; float ssa = 0.f;
#pragma unroll
            for (int j = 0; j < 3; ++j) { const v4u raw = *(const v4u*)(Oa + (size_t)row * AQW + 8 * (lane + 64 * j));
                oa[8 * j + 0] = bflo(raw.x); oa[8 * j + 1] = bfhi(raw.x); oa[8 * j + 2] = bflo(raw.y); oa[8 * j + 3] = bfhi(raw.y); oa[8 * j + 4] = bflo(raw.z); oa[8 * j + 5] = bfhi(raw.z); oa[8 * j + 6] = bflo(raw.w); oa[8 * j + 7] = bfhi(raw.w); }
#pragma unroll
            for (int i = 0; i < 24; ++i) ssa += oa[i] * oa[i];
            const float rsa = rsqrtf(wave_sum(ssa) * (1.f / 1536.f) + NORM_EPS);
            const int h = lane >> 3;
            const float l0 = Lse[((size_t)0 * MTOK + row) * 8 + h], l1 = Lse[((size_t)1 * MTOK + row) * 8 + h], l2 = Lse[((size_t)2 * MTOK + row) * 8 + h];
            const float lm = fmaxf(l0, fmaxf(l1, l2));
            float w0 = __builtin_amdgcn_exp2f(l0 - lm), w1 = __builtin_amdgcn_exp2f(l1 - lm), w2 = __builtin_amdgcn_exp2f(l2 - lm);
            const float wi = 1.0f / (w0 + w1 + w2); w0 *= wi; w1 *= wi; w2 *= wi;
            const v4u r0 = *(const v4u*)(Ob + ((size_t)0 * MTOK + row) * BW + 8 * lane), r1 = *(const v4u*)(Ob + ((size_t)1 * MTOK + row) * BW + 8 * lane), r2 = *(const v4u*)(Ob + ((size_t)2 * MTOK + row) * BW + 8 * lane);
            float ob[8];
            ob[0] = w0 * bflo(r0.x) + w1 * bflo(r1.x) + w2 * bflo(r2.x); ob[1] = w0 * bfhi(r0.x) + w1 * bfhi(r1.x) + w2 * bfhi(r2.x);
            ob[2] = w0 * bflo(r0.y) + w1 * bflo(r1.y) + w2 * bflo(r2.y); ob[3] = w0 * bfhi(r0.y) + w1 * bfhi(r1.y) + w2 * bfhi(r2.y);
            ob[4] = w0 * bflo(r0.z) + w1 * bflo(r1.z) + w2 * bflo(r2.z); ob[5] = w0 * bfhi(r0.z) + w1 * bfhi(r1.z) + w2 * bfhi(r2.z);
            ob[6] = w0 * bflo(r0.w) + w1 * bflo(r1.w) + w2 * bflo(r2.w); ob[7] = w0 * bfhi(r0.w) + w1 * bfhi(r1.w) + w2 * bfhi(r2.w);
            float ssb = 0.f;
#pragma unroll
            for (int i = 0; i < 8; ++i) ssb += ob[i] * ob[i];
            const float rsb = rsqrtf(wave_sum(ssb) * (1.f / 512.f) + NORM_EPS);
            bf16* mrow = Mg + (size_t)row * DM;
#pragma unroll
            for (int j = 0; j < 3; ++j) { const int c = 8 * (lane + 64 * j); const f32x4 wa = onw[2 * j], wb = onw[2 * j + 1];
                v4u o; o.x = pk2(oa[8 * j + 0] * rsa * wa.x, oa[8 * j + 1] * rsa * wa.y); o.y = pk2(oa[8 * j + 2] * rsa * wa.z, oa[8 * j + 3] * rsa * wa.w);
                o.z = pk2(oa[8 * j + 4] * rsa * wb.x, oa[8 * j + 5] * rsa * wb.y); o.w = pk2(oa[8 * j + 6] * rsa * wb.z, oa[8 * j + 7] * rsa * wb.w); *(v4u*)(mrow + c) = o; }
            { const int c = AQW + 8 * lane; const f32x4 wa = onw[6], wb = onw[7];
                v4u o; o.x = pk2(ob[0] * rsb * wa.x, ob[1] * rsb * wa.y); o.y = pk2(ob[2] * rsb * wa.z, ob[3] * rsb * wa.w); o.z = pk2(ob[4] * rsb * wb.x, ob[5] * rsb * wb.y); o.w = pk2(ob[6] * rsb * wb.z, ob[7] * rsb * wb.w); *(v4u*)(mrow + c) = o; }
        }
        }
        if (BOTH(4)) GRID_BAR();
    }

    if (IN(5)) { PHASE_REP(5) {
        PHASE_LANE();
        pg8::StaticOrder S; S.init(MTOK / 256, DM / 256, G, bx);
        pg8::EpiResidBf16 E{x, X1, DM};
        pg8::gemm_phase<pg8::EpiResidBf16, pg8::StaticOrder, true, true>((PG8_LAS unsigned char*)lds + RING_OFF, DM, (const char*)Mg, (const char*)WoutT, S, E);
        }
        if (BOTH(5)) GRID_BAR();
    }

    if (IN(6)) { PHASE_REP(6) {
        PHASE_LANE();
        int* lcnt = (int*)(lds + CNT_OFF); int* lbase = lcnt + 32; int* le = (int*)(lds + ROUTE_OFF); int* lrank = le + 512;
        float* logit = (float*)(lds + LOGIT_OFF); unsigned char* tile = lds + RING_OFF; float* part = (float*)(lds + RING_OFF);
        const int r32 = lane & 31, hi = lane >> 5;
        f32x4 wmo[8];
#pragma unroll
        for (int j = 0; j < 4; ++j) { wmo[2 * j] = *(const f32x4*)(norm_moe_w + 8 * (lane + 64 * j)); wmo[2 * j + 1] = *(const f32x4*)(norm_moe_w + 8 * (lane + 64 * j) + 4); }
        for (int chunk = bx; chunk < MTOK / 128; chunk += G) {
            if (tid < 32) lcnt[tid] = 0;
            __syncthreads();
#pragma unroll 1
            for (int grp = 0; grp < 4; ++grp) {
                const int row0 = chunk * 128 + grp * 32;
                v4u xr_[4][4];
#pragma unroll
                for (int rr = 0; rr < 4; ++rr)
#pragma unroll
                    for (int j = 0; j < 4; ++j) xr_[rr][j] = ((const v4u*)(X1 + ((size_t)row0 + 4 * wave + rr) * DM))[lane + 64 * j];
                __builtin_amdgcn_sched_barrier(0);
#pragma unroll
                for (int rr = 0; rr < 4; ++rr) {
                    const int r = 4 * wave + rr; const size_t grow = (size_t)row0 + r;
                    float xv[4][8]; float ss = 0.f;
#pragma unroll
                    for (int j = 0; j < 4; ++j) { const v4u q = xr_[rr][j]; xv[j][0] = bflo(q.x); xv[j][1] = bfhi(q.x); xv[j][2] = bflo(q.y); xv[j][3] = bfhi(q.y); xv[j][4] = bflo(q.z); xv[j][5] = bfhi(q.z); xv[j][6] = bflo(q.w); xv[j][7] = bfhi(q.w);
#pragma unroll
                        for (int i = 0; i < 8; ++i) ss += xv[j][i] * xv[j][i]; }
                    const float rstd = rsqrtf(wave_sum(ss) * (1.f / 2048.f) + NORM_EPS);
#pragma unroll
                    for (int j = 0; j < 4; ++j) { const f32x4 wa = wmo[2 * j], wb = wmo[2 * j + 1];
                        const float h0 = xv[j][0] * rstd * wa.x, h1 = xv[j][1] * rstd * wa.y, h2 = xv[j][2] * rstd * wa.z, h3 = xv[j][3] * rstd * wa.w;
                        const float h4 = xv[j][4] * rstd * wb.x, h5 = xv[j][5] * rstd * wb.y, h6 = xv[j][6] * rstd * wb.z, h7 = xv[j][7] * rstd * wb.w;
                        v4u o; o.x = pk2(h0, h1); o.y = pk2(h2, h3); o.z = pk2(h4, h5); o.w = pk2(h6, h7);
                        v2u o8; o8.x = pg8::pk4_fp8(h0, h1, h2, h3); o8.y = pg8::pk4_fp8(h4, h5, h6, h7);
                        ((v2u*)(Hn8 + grow * DM))[lane + 64 * j] = o8;
                        *(v4u*)(tile + (lane + 64 * j) * 512 + r * 16) = o; }
                }
                __syncthreads();
                f32x16 acc = f32x16{};
#pragma unroll 4
                for (int s = 0; s < 16; ++s) { const int kk = 16 * wave + s;
                    const bf16x8 a = *(const bf16x8*)(tile + ((kk * 2 + hi) * 32 + r32) * 16);
                    const bf16x8 b = *(const bf16x8*)(WrT + (size_t)r32 * 2048 + 16 * kk + 8 * hi);
                    acc = __builtin_amdgcn_mfma_f32_32x32x16_bf16(a, b, acc, 0, 0, 0); }
                __syncthreads();
#pragma unroll
                for (int r = 0; r < 16; ++r) part[(wave * 32 + ((r & 3) + 8 * (r >> 2) + 4 * hi)) * 33 + r32] = acc[r];
                __syncthreads();
#pragma unroll
                for (int q = 0; q < 2; ++q) { const int idx = tid * 2 + q, row = idx >> 5, e = idx & 31; float sm = 0.f;
#pragma unroll
                    for (int w = 0; w < 8; ++w) sm += part[(w * 32 + row) * 33 + e];
                    logit[row * 33 + e] = sm + b_router[e]; }
                __syncthreads();
                if (tid < 32) { const int row = tid; unsigned taken = 0u; float tv[4]; int te[4];
#pragma unroll
                    for (int k = 0; k < 4; ++k) { float best = -INFINITY; int bi = 0;
                        for (int e = 0; e < 32; ++e) { const float v = logit[row * 33 + e]; const bool ok = !((taken >> e) & 1u) && (v > best); best = ok ? v : best; bi = ok ? e : bi; }
                        taken |= 1u << bi; tv[k] = best; te[k] = bi; }
                    float ex[4], sum = 0.f;
#pragma unroll
                    for (int k = 0; k < 4; ++k) { ex[k] = __builtin_amdgcn_exp2f((tv[k] - tv[0]) * 1.4426950408889634f); sum += ex[k]; }
                    const float inv = 1.0f / sum; const size_t grow = (size_t)row0 + row;
                    f32x4 gv = {ex[0] * inv, ex[1] * inv, ex[2] * inv, ex[3] * inv}; *(f32x4*)(Gate + grow * 4) = gv;
#pragma unroll
                    for (int k = 0; k < 4; ++k) { const int lr = __hip_atomic_fetch_add(lcnt + te[k], 1, __ATOMIC_RELAXED, __HIP_MEMORY_SCOPE_WORKGROUP); le[(grp * 32 + row) * 4 + k] = te[k]; lrank[(grp * 32 + row) * 4 + k] = lr; }
                }
                __syncthreads();
            }
            if (tid < 32) lbase[tid] = (int)__hip_atomic_fetch_add(gcnt + tid, (unsigned)lcnt[tid], RLX_AGENT);
            __syncthreads();
            { const size_t gi = (size_t)chunk * 512 + tid; const int e = le[tid]; const int rk = lbase[e] + lrank[tid]; Eidx[gi] = e; Rank[gi] = rk; TokOf[(size_t)e * 32768 + rk] = (int)(gi >> 2); }
            __syncthreads();
        }
        }
        if (BOTH(6)) GRID_BAR();
    }


    if (IN(8)) { PHASE_REP(8) {
        PHASE_LANE();
        moe_tables(gcnt, tile_e, ppad, ecnt, tid);
        pg8::MoeGatherOrder S; S.so.init(__builtin_amdgcn_readfirstlane(ppad[33]), 16, G, bx); S.tile_e = (const PG8_LAS int*)tile_e; S.ppad = (const PG8_LAS int*)ppad; S.ecnt = (const PG8_LAS int*)ecnt;
        S.tokof = TokOf; S.tokbuf = (PG8_LAS int*)tokbuf; S.dt.init(ctl + CW_Q8, (PG8_LAS int*)(lds + QW_OFF), S.so.nwg, G);
        pg8::EpiSwiglu E{Hact8, b_gate_up, WSC_INV, (PG8_LAS float*)(lds + LOGIT_OFF)};
        pg8::gemm_phase<pg8::EpiSwiglu, pg8::MoeGatherOrder, true, true, true, true>((PG8_LAS unsigned char*)lds + RING_OFF, DM / 2, (const char*)Hn8, (const char*)Wgu8, S, E);
        }
        if (BOTH(8)) GRID_BAR();
    }

    if (IN(9)) { PHASE_REP(9) {
        PHASE_LANE();
        moe_tables(gcnt, tile_e, ppad, ecnt, tid);
        pg8::MoeOrder S; S.so.init(__builtin_amdgcn_readfirstlane(ppad[33]), 8, G, bx); S.tile_e = (const PG8_LAS int*)tile_e; S.dt.init(ctl + CW_Q9, (PG8_LAS int*)(lds + QW_OFF), S.so.nwg, G);
        pg8::EpiFp8 E{Y8, DM, b_down, DM, WSC_INV, (PG8_LAS float*)(lds + LOGIT_OFF)};
        pg8::gemm_phase<pg8::EpiFp8, pg8::MoeOrder, true, true, true>((PG8_LAS unsigned char*)lds + RING_OFF, DM / 2, (const char*)Hact8, (const char*)Wd8, S, E);
        }
        if (BOTH(9)) GRID_BAR();
    }

    if (IN(10)) { PHASE_REP(10) {
        PHASE_LANE();
        moe_tables(gcnt, tile_e, ppad, ecnt, tid);
        f32x4 fw[8];
#pragma unroll
        for (int j = 0; j < 4; ++j) { fw[2 * j] = *(const f32x4*)(final_norm_w + 8 * (lane + 64 * j)); fw[2 * j + 1] = *(const f32x4*)(final_norm_w + 8 * (lane + 64 * j) + 4); }
        for (int row = gw; row < MTOK; row += NGW) {
            const f32x4 gv = *(const f32x4*)(Gate + (size_t)row * 4);
            const int p0 = ppad[Eidx[(size_t)row * 4 + 0]] + Rank[(size_t)row * 4 + 0], p1 = ppad[Eidx[(size_t)row * 4 + 1]] + Rank[(size_t)row * 4 + 1];
            const int p2 = ppad[Eidx[(size_t)row * 4 + 2]] + Rank[(size_t)row * 4 + 2], p3 = ppad[Eidx[(size_t)row * 4 + 3]] + Rank[(size_t)row * 4 + 3];
            v4u xq[4]; v2u yq[4][4];
#pragma unroll
            for (int j = 0; j < 4; ++j) xq[j] = ((const v4u*)(X1 + (size_t)row * DM))[lane + 64 * j];
#pragma unroll
            for (int j = 0; j < 4; ++j) { yq[0][j] = ((const v2u*)(Y8 + (size_t)p0 * DM))[lane + 64 * j]; yq[1][j] = ((const v2u*)(Y8 + (size_t)p1 * DM))[lane + 64 * j];
                yq[2][j] = ((const v2u*)(Y8 + (size_t)p2 * DM))[lane + 64 * j]; yq[3][j] = ((const v2u*)(Y8 + (size_t)p3 * DM))[lane + 64 * j]; }
            __builtin_amdgcn_sched_barrier(0);
            float v[4][8]; float ss = 0.f;
#pragma unroll
            for (int j = 0; j < 4; ++j) { const v4u q = xq[j]; v[j][0] = bflo(q.x); v[j][1] = bfhi(q.x); v[j][2] = bflo(q.y); v[j][3] = bfhi(q.y); v[j][4] = bflo(q.z); v[j][5] = bfhi(q.z); v[j][6] = bflo(q.w); v[j][7] = bfhi(q.w);
#pragma unroll
                for (int k = 0; k < 4; ++k) { const float g = gv[k]; const v2u y = yq[k][j];
                    const f32x2 a = __builtin_amdgcn_cvt_pk_f32_fp8((int)y.x, false), b = __builtin_amdgcn_cvt_pk_f32_fp8((int)y.x, true), c = __builtin_amdgcn_cvt_pk_f32_fp8((int)y.y, false), d = __builtin_amdgcn_cvt_pk_f32_fp8((int)y.y, true);
                    v[j][0] += g * a.x; v[j][1] += g * a.y; v[j][2] += g * b.x; v[j][3] += g * b.y; v[j][4] += g * c.x; v[j][5] += g * c.y; v[j][6] += g * d.x; v[j][7] += g * d.y; }
#pragma unroll
                for (int i = 0; i < 8; ++i) ss += v[j][i] * v[j][i]; }
            const float rstd = rsqrtf(wave_sum(ss) * (1.f / 2048.f) + NORM_EPS);
            float* orow = out + (size_t)row * DM;
#pragma unroll
            for (int j = 0; j < 4; ++j) { const f32x4 wa = fw[2 * j], wb = fw[2 * j + 1]; const int c = 8 * (lane + 64 * j);
                f32x4 o0 = {v[j][0] * rstd * wa.x, v[j][1] * rstd * wa.y, v[j][2] * rstd * wa.z, v[j][3] * rstd * wa.w}, o1 = {v[j][4] * rstd * wb.x, v[j][5] * rstd * wb.y, v[j][6] * rstd * wb.z, v[j][7] * rstd * wb.w};
                *(f32x4*)(orow + c) = o0; *(f32x4*)(orow + c + 4) = o1; }
        }
        }
    }
#undef IN
#undef BOTH
}

extern "C" void kernel_launch(void* const* d_in, const int* in_sizes, int n_in, void* d_out, int out_size, void* d_ws, size_t ws_size, hipStream_t stream) {
    static int grid = 0;
    if (grid == 0) {
        if (n_in != 15 || in_sizes[0] != MTOK * DM || out_size != MTOK * DM || ws_size < WS_END) { fprintf(stderr, "kernel_launch: unexpected shapes / workspace (n_in %d, ws %zu < %zu); nothing launched\n", n_in, ws_size, (size_t)WS_END); grid = -1; return; }
        int dev = 0, cus = 0, per_cu = 0;
        if (hipGetDevice(&dev) != hipSuccess || hipDeviceGetAttribute(&cus, hipDeviceAttributeMultiprocessorCount, dev) != hipSuccess) { grid = -1; return; }
        if (hipFuncSetAttribute((const void*)mk_fwd, hipFuncAttributeMaxDynamicSharedMemorySize, LDS_BYTES) != hipSuccess) { fprintf(stderr, "kernel_launch: hipFuncSetAttribute failed\n"); grid = -1; return; }
        if (hipOccupancyMaxActiveBlocksPerMultiprocessor(&per_cu, (const void*)mk_fwd, NWAVES * 64, LDS_BYTES) != hipSuccess || per_cu < 1) fprintf(stderr, "kernel_launch: occupancy query reports %d blocks per CU\n", per_cu);
        (void)hipGetLastError();
        grid = cus;
    }
    if (grid < 0) return;
    if (hipMemsetAsync((char*)d_ws + WS_CTL, 0, CTL_ZERO_BYTES, stream) != hipSuccess) return;
    Args a{};
    for (int i = 0; i < 15; ++i) a.in[i] = (const float*)d_in[i];
    a.out = (float*)d_out; a.ws = (unsigned char*)d_ws;
#if MK_SPLIT
    for (int k = 0; k < N_PHASES; ++k) { a.ph_lo = k; a.ph_hi = k + 1; hipLaunchKernelGGL(mk_fwd, dim3(grid), dim3(NWAVES * 64), LDS_BYTES, stream, a); }
#else
    a.ph_lo = 0; a.ph_hi = N_PHASES;
    hipLaunchKernelGGL(mk_fwd, dim3(grid), dim3(NWAVES * 64), LDS_BYTES, stream, a);
#endif
    const hipError_t le = hipPeekAtLastError();
    if (le != hipSuccess) fprintf(stderr, "kernel_launch: launch failed: %s\n", hipGetErrorName(le));
}
```
